# Optimizing an MI355X kernel written in HIP

```python
import jax
import jax.numpy as jnp
from jax import lax
import numpy as np

D_MODEL = 1024
BATCH = 8
SEQ = 4096
DEPTH = 2

HEAD_DIM = 64
ROPE_DIM = HEAD_DIM // 4
ROPE_THETA = 500000.0
Q_BLOCK = 128
NORM_EPS = 1e-6
N_EVEN = (DEPTH + 1) // 2
N_ODD = DEPTH // 2

DSA_HEADS = D_MODEL // HEAD_DIM
DSA_NOPE = HEAD_DIM - ROPE_DIM
DSA_V_DIM = HEAD_DIM
DSA_Q_LORA = D_MODEL // 4
DSA_KV_LORA = D_MODEL // 8
IDX_HEADS = 8
IDX_DIM = 64
DSA_TOPK = 256
DSA_IN = DSA_Q_LORA + DSA_KV_LORA + ROPE_DIM + IDX_DIM + IDX_HEADS

NSA_HEADS = D_MODEL // HEAD_DIM
NSA_GROUPS = 4
NSA_HPG = NSA_HEADS // NSA_GROUPS
CMP_LEN = 32
CMP_STRIDE = 16
CMP_HIDDEN = 256
SEL_LEN = 64
SEL_BLOCKS = 16
WINDOW = 512
FORCE_SCORE = 1e4
NSA_KV = NSA_GROUPS * HEAD_DIM
NSA_IN = NSA_HEADS * HEAD_DIM + 6 * NSA_KV + 3 * NSA_HEADS

FFN_DIM = 2816
N_EXPERTS = 8
TOP_K = 2
EXPERT_DIM = 3584
MOE_BLOCK = 512

kernel_name = 'hybrid_dsa_nsa_moe_adaln'


def rmsnorm(x, g):
    xf = x.astype(jnp.float32)
    y = xf * lax.rsqrt(jnp.mean(xf * xf, axis=-1, keepdims=True) + NORM_EPS)
    return (y * g.astype(jnp.float32)).astype(x.dtype)


def rope_tables(seq):
    inv = ROPE_THETA ** (-jnp.arange(0, ROPE_DIM, 2, dtype=jnp.float32) / ROPE_DIM)
    ang = jnp.arange(seq, dtype=jnp.float32)[:, None] * inv[None, :]
    return jnp.cos(ang), jnp.sin(ang)


def apply_partial_rope(x, cos, sin):
    shp = (cos.shape[0],) + (1,) * (x.ndim - 3) + (cos.shape[1],)
    co, si = cos.reshape(shp), sin.reshape(shp)
    half = ROPE_DIM // 2
    xr = x[..., :ROPE_DIM].astype(jnp.float32)
    x1, x2 = xr[..., :half], xr[..., half:]
    rot = jnp.concatenate([x1 * co - x2 * si, x2 * co + x1 * si], axis=-1).astype(x.dtype)
    return jnp.concatenate([rot, x[..., ROPE_DIM:]], axis=-1)


def masked_softmax(s, valid):
    s = jnp.where(valid, s.astype(jnp.float32), -jnp.inf)
    m = jnp.max(s, axis=-1, keepdims=True)
    m = jnp.where(jnp.isfinite(m), m, 0.0)
    e = jnp.where(valid, jnp.exp(s - m), 0.0)
    return e / jnp.maximum(jnp.sum(e, axis=-1, keepdims=True), 1e-30)


def modulate(x, c, norm_g, w_ada, b_ada):
    mod = jax.nn.silu(c) @ w_ada + b_ada
    shift, scale, gate = jnp.split(mod, 3, axis=-1)
    h = rmsnorm(x, norm_g) * (1.0 + scale[:, None, :]) + shift[:, None, :]
    return h, gate[:, None, :]


def sweep_query_blocks(fn, batch, seq):
    nq = seq // Q_BLOCK
    out = lax.map(lambda i: fn(i // nq, (i % nq) * Q_BLOCK), jnp.arange(batch * nq))
    return out.reshape((batch, seq) + out.shape[2:])


def dsa_mixer(h, cos, sin, w_in, g_q, w_uq, g_kv, w_uk, w_uv, w_iq, w_o):
    B, S, _ = h.shape
    proj = h @ w_in
    cuts = np.cumsum([DSA_Q_LORA, DSA_KV_LORA, ROPE_DIM, IDX_DIM]).tolist()
    q_lat, kv_lat, k_rope, idx_k, idx_w = jnp.split(proj, cuts, axis=-1)
    q_lat = rmsnorm(q_lat, g_q)
    q = apply_partial_rope((q_lat @ w_uq).reshape(B, S, DSA_HEADS, HEAD_DIM), cos, sin)
    q_rope, q_nope = q[..., :ROPE_DIM], q[..., ROPE_DIM:]
    q_abs = jnp.einsum('bshn,hcn->bshc', q_nope, w_uk)
    q_cat = jnp.concatenate([q_rope, q_abs], axis=-1)
    c_kv = rmsnorm(kv_lat, g_kv)
    k_cat = jnp.concatenate([apply_partial_rope(k_rope, cos, sin), c_kv], axis=-1)
    iq = apply_partial_rope((q_lat @ w_iq).reshape(B, S, IDX_HEADS, IDX_DIM), cos, sin)
    ik = apply_partial_rope(idx_k, cos, sin)
    iw = idx_w.astype(jnp.float32) * (IDX_HEADS ** -0.5)
    k_sel = min(DSA_TOPK, S // 4)
    scale = HEAD_DIM ** -0.5

    def block(b, qs):
        t = qs + jnp.arange(Q_BLOCK)
        causal = jnp.arange(S)[None, :] <= t[:, None]
        iq_b = lax.dynamic_slice_in_dim(iq[b], qs, Q_BLOCK, 0)
        iw_b = lax.dynamic_slice_in_dim(iw[b], qs, Q_BLOCK, 0)
        logits = jnp.einsum('qhd,sd->qhs', iq_b, ik[b]).astype(jnp.float32) * (IDX_DIM ** -0.5)
        score = jnp.einsum('qhs,qh->qs', jax.nn.relu(logits), iw_b)
        score = jnp.where(causal, score, -jnp.inf)
        _, sel = lax.top_k(score, k_sel)
        kv = k_cat[b][sel]
        q_b = lax.dynamic_slice_in_dim(q_cat[b], qs, Q_BLOCK, 0)
        s = jnp.einsum('qhd,qkd->qhk', q_b, kv) * scale
        p = masked_softmax(s, (sel <= t[:, None])[:, None, :]).astype(kv.dtype)
        return jnp.einsum('qhk,qkc->qhc', p, kv[..., ROPE_DIM:])

    o_lat = sweep_query_blocks(block, B, S)
    o = jnp.einsum('bshc,hcv->bshv', o_lat, w_uv).reshape(B, S, DSA_HEADS * DSA_V_DIM)
    return o @ w_o


def nsa_mixer(h, cos, sin, w_in, cmp_pe, cmp_k1, cmp_k2, cmp_v1, cmp_v2, w_o):
    B, S, _ = h.shape
    G, HD = NSA_GROUPS, HEAD_DIM
    proj = h @ w_in
    cuts = np.cumsum([NSA_HEADS * HD] + [NSA_KV] * 6).tolist()
    q, kc, vc, ks, vs, kw, vw, g = jnp.split(proj, cuts, axis=-1)
    q = apply_partial_rope(q.reshape(B, S, NSA_HEADS, HD), cos, sin)
    kc = apply_partial_rope(kc.reshape(B, S, G, HD), cos, sin)
    ks = apply_partial_rope(ks.reshape(B, S, G, HD), cos, sin)
    kw = apply_partial_rope(kw.reshape(B, S, G, HD), cos, sin)
    vc, vs, vw = (v.reshape(B, S, G, HD) for v in (vc, vs, vw))
    gates = jax.nn.sigmoid(g.astype(jnp.float32)).reshape(B, S, NSA_HEADS, 3)

    nc = (S - CMP_LEN) // CMP_STRIDE + 1
    tok = jnp.arange(nc)[:, None] * CMP_STRIDE + jnp.arange(CMP_LEN)[None, :]

    def compress(arr, w1, w2):
        blk = arr[:, tok] + cmp_pe[:, None, :]
        blk = blk.transpose(0, 1, 3, 2, 4).reshape(B, nc, G, CMP_LEN * HD)
        return jax.nn.silu(blk @ w1) @ w2

    kcmp = compress(kc, cmp_k1, cmp_k2)
    vcmp = compress(vc, cmp_v1, cmp_v2)
    cmp_end = jnp.arange(nc) * CMP_STRIDE + CMP_LEN - 1

    nb = S // SEL_LEN
    n_sel = min(SEL_BLOCKS, nb)
    ks_blk = ks.reshape(B, nb, SEL_LEN, G, HD).transpose(0, 3, 1, 2, 4)
    vs_blk = vs.reshape(B, nb, SEL_LEN, G, HD).transpose(0, 3, 1, 2, 4)
    cstart = jnp.arange(nc) * CMP_STRIDE
    bstart = jnp.arange(nb) * SEL_LEN
    cover = ((cstart[:, None] < bstart[None, :] + SEL_LEN)
             & (cstart[:, None] + CMP_LEN > bstart[None, :])).astype(jnp.float32)

    kw_pad = jnp.pad(kw, ((0, 0), (WINDOW, 0), (0, 0), (0, 0)))
    vw_pad = jnp.pad(vw, ((0, 0), (WINDOW, 0), (0, 0), (0, 0)))
    scale = HD ** -0.5
    gidx = jnp.arange(G)[None, :, None]

    def block(b, qs):
        t = qs + jnp.arange(Q_BLOCK)
        qb = lax.dynamic_slice_in_dim(q[b], qs, Q_BLOCK, 0).reshape(Q_BLOCK, G, NSA_HPG, HD)
        sc = jnp.einsum('qghd,ngd->qghn', qb, kcmp[b]) * scale
        pc = masked_softmax(sc, (cmp_end[None, :] <= t[:, None])[:, None, None, :])
        oc = jnp.einsum('qghn,ngd->qghd', pc.astype(qb.dtype), vcmp[b])
        imp = jnp.einsum('qgn,nj->qgj', jnp.sum(pc, axis=2), cover)
        jb = jnp.arange(nb)[None, :]
        cur = (t // SEL_LEN)[:, None]
        forced = (jb == 0) | (jb == cur) | (jb == cur - 1)
        imp = jnp.where(forced[:, None, :], FORCE_SCORE, imp)
        imp = jnp.where((jb <= cur)[:, None, :], imp, -jnp.inf)
        _, sel = lax.top_k(imp, n_sel)
        kb = ks_blk[b][gidx, sel].reshape(Q_BLOCK, G, n_sel * SEL_LEN, HD)
        vb = vs_blk[b][gidx, sel].reshape(Q_BLOCK, G, n_sel * SEL_LEN, HD)
        pos = (sel[..., None] * SEL_LEN + jnp.arange(SEL_LEN)).reshape(Q_BLOCK, G, n_sel * SEL_LEN)
        ss = jnp.einsum('qghd,qgkd->qghk', qb, kb) * scale
        ps = masked_softmax(ss, (pos <= t[:, None, None])[:, :, None, :])
        osel = jnp.einsum('qghk,qgkd->qghd', ps.astype(qb.dtype), vb)
        kwb = lax.dynamic_slice_in_dim(kw_pad[b], qs, WINDOW + Q_BLOCK, 0)
        vwb = lax.dynamic_slice_in_dim(vw_pad[b], qs, WINDOW + Q_BLOCK, 0)
        kpos = qs - WINDOW + jnp.arange(WINDOW + Q_BLOCK)
        wmask = ((kpos[None, :] <= t[:, None]) & (kpos[None, :] > t[:, None] - WINDOW)
                 & (kpos[None, :] >= 0))
        sw = jnp.einsum('qghd,kgd->qghk', qb, kwb) * scale
        pw = masked_softmax(sw, wmask[:, None, None, :])
        ow = jnp.einsum('qghk,kgd->qghd', pw.astype(qb.dtype), vwb)
        gb = lax.dynamic_slice_in_dim(gates[b], qs, Q_BLOCK, 0).reshape(Q_BLOCK, G, NSA_HPG, 3)
        o = gb[..., 0:1] * oc + gb[..., 1:2] * osel + gb[..., 2:3] * ow
        return o.astype(qb.dtype).reshape(Q_BLOCK, NSA_HEADS * HD)

    o = sweep_query_blocks(block, B, S)
    return o @ w_o


def swiglu(h, w1, w3, w2):
    return (jax.nn.silu(h @ w1) * (h @ w3)) @ w2


def moe_swiglu(h, w_router, w1, w3, w2):
    B, S, D = h.shape
    T = B * S
    hf = h.reshape(T, D)
    logits = (hf @ w_router).astype(jnp.float32)
    top_val, top_idx = lax.top_k(logits, TOP_K)
    gate = jax.nn.softmax(top_val, axis=-1)
    flat_e = top_idx.reshape(-1)
    flat_tok = jnp.repeat(jnp.arange(T), TOP_K)
    order = jnp.argsort(flat_e)
    e_sorted = flat_e[order]
    tok_sorted = flat_tok[order]
    gate_sorted = gate.reshape(-1)[order]
    counts = jnp.bincount(flat_e, length=N_EXPERTS)
    padded = (counts + MOE_BLOCK - 1) // MOE_BLOCK * MOE_BLOCK
    ends = jnp.cumsum(padded)
    pstart = ends - padded
    gstart = jnp.cumsum(counts) - counts
    dest = pstart[e_sorted] + (jnp.arange(T * TOP_K) - gstart[e_sorted])
    n_blocks = -(-(T * TOP_K) // MOE_BLOCK) + N_EXPERTS
    slot_tok = jnp.full((n_blocks * MOE_BLOCK,), T, jnp.int32).at[dest].set(tok_sorted)
    block_e = jnp.minimum(jnp.searchsorted(ends, jnp.arange(n_blocks) * MOE_BLOCK, side='right'),
                          N_EXPERTS - 1)
    h_pad = jnp.concatenate([hf, jnp.zeros((1, D), hf.dtype)], axis=0)

    def run(i):
        rows = lax.dynamic_slice_in_dim(slot_tok, i * MOE_BLOCK, MOE_BLOCK)
        e = block_e[i]
        return swiglu(h_pad[rows], w1[e], w3[e], w2[e])

    ys = lax.map(run, jnp.arange(n_blocks)).reshape(-1, D)
    y = ys[dest] * gate_sorted[:, None].astype(ys.dtype)
    return jax.ops.segment_sum(y, tok_sorted, num_segments=T).reshape(B, S, D)


def setup_inputs(seed: int = 0) -> dict:
    key = jax.random.key(seed)
    ks = iter(jax.random.split(key, 40))
    D = D_MODEL

    def w(shape, fan_in):
        return jax.random.normal(next(ks), shape, jnp.float32) * (fan_in ** -0.5)

    def gain(shape):
        return 1.0 + 0.05 * jax.random.normal(next(ks), shape, jnp.float32)

    def small(shape, s):
        return s * jax.random.normal(next(ks), shape, jnp.float32)

    return {
        'x': jax.random.normal(next(ks), (BATCH, SEQ, D), jnp.float32),
        'c': jax.random.normal(next(ks), (BATCH, D), jnp.float32),
        'norm_mix': gain((DEPTH, D)),
        'norm_ffn': gain((DEPTH, D)),
        'ada_w': 0.5 * w((DEPTH, 2, D, 3 * D), D),
        'ada_b': small((DEPTH, 2, 3 * D), 0.02),
        'final_norm': gain((D,)),
        'dsa_w_in': w((N_EVEN, D, DSA_IN), D),
        'dsa_g_q': gain((N_EVEN, DSA_Q_LORA)),
        'dsa_w_uq': w((N_EVEN, DSA_Q_LORA, DSA_HEADS * HEAD_DIM), DSA_Q_LORA),
        'dsa_g_kv': gain((N_EVEN, DSA_KV_LORA)),
        'dsa_w_uk': w((N_EVEN, DSA_HEADS, DSA_KV_LORA, DSA_NOPE), DSA_KV_LORA),
        'dsa_w_uv': w((N_EVEN, DSA_HEADS, DSA_KV_LORA, DSA_V_DIM), DSA_KV_LORA),
        'dsa_w_iq': w((N_EVEN, DSA_Q_LORA, IDX_HEADS * IDX_DIM), DSA_Q_LORA),
        'dsa_w_o': w((N_EVEN, DSA_HEADS * DSA_V_DIM, D), DSA_HEADS * DSA_V_DIM),
        'ffn_w1': w((N_EVEN, D, FFN_DIM), D),
        'ffn_w3': w((N_EVEN, D, FFN_DIM), D),
        'ffn_w2': w((N_EVEN, FFN_DIM, D), FFN_DIM),
        'nsa_w_in': w((N_ODD, D, NSA_IN), D),
        'nsa_cmp_pe': small((N_ODD, CMP_LEN, HEAD_DIM), 0.1),
        'nsa_cmp_k1': w((N_ODD, CMP_LEN * HEAD_DIM, CMP_HIDDEN), CMP_LEN * HEAD_DIM),
        'nsa_cmp_k2': w((N_ODD, CMP_HIDDEN, HEAD_DIM), CMP_HIDDEN),
        'nsa_cmp_v1': w((N_ODD, CMP_LEN * HEAD_DIM, CMP_HIDDEN), CMP_LEN * HEAD_DIM),
        'nsa_cmp_v2': w((N_ODD, CMP_HIDDEN, HEAD_DIM), CMP_HIDDEN),
        'nsa_w_o': w((N_ODD, NSA_HEADS * HEAD_DIM, D), NSA_HEADS * HEAD_DIM),
        'moe_router': w((N_ODD, D, N_EXPERTS), D),
        'moe_w1': w((N_ODD, N_EXPERTS, D, EXPERT_DIM), D),
        'moe_w3': w((N_ODD, N_EXPERTS, D, EXPERT_DIM), D),
        'moe_w2': w((N_ODD, N_EXPERTS, EXPERT_DIM, D), EXPERT_DIM),
    }


def reference(x, c, norm_mix, norm_ffn, ada_w, ada_b, final_norm,
              dsa_w_in, dsa_g_q, dsa_w_uq, dsa_g_kv, dsa_w_uk, dsa_w_uv, dsa_w_iq, dsa_w_o,
              ffn_w1, ffn_w3, ffn_w2,
              nsa_w_in, nsa_cmp_pe, nsa_cmp_k1, nsa_cmp_k2, nsa_cmp_v1, nsa_cmp_v2, nsa_w_o,
              moe_router, moe_w1, moe_w3, moe_w2):
    cos, sin = rope_tables(x.shape[1])
    for i in range(DEPTH):
        j = i // 2
        h, gate = modulate(x, c, norm_mix[i], ada_w[i, 0], ada_b[i, 0])
        if i % 2 == 0:
            mix = dsa_mixer(h, cos, sin, dsa_w_in[j], dsa_g_q[j], dsa_w_uq[j], dsa_g_kv[j],
                            dsa_w_uk[j], dsa_w_uv[j], dsa_w_iq[j], dsa_w_o[j])
        else:
            mix = nsa_mixer(h, cos, sin, nsa_w_in[j], nsa_cmp_pe[j], nsa_cmp_k1[j], nsa_cmp_k2[j],
                            nsa_cmp_v1[j], nsa_cmp_v2[j], nsa_w_o[j])
        x = x + gate * mix
        h, gate = modulate(x, c, norm_ffn[i], ada_w[i, 1], ada_b[i, 1])
        if i % 2 == 0:
            f = swiglu(h, ffn_w1[j], ffn_w3[j], ffn_w2[j])
        else:
            f = moe_swiglu(h, moe_router[j], moe_w1[j], moe_w3[j], moe_w2[j])
        x = x + gate * f
    return rmsnorm(x, final_norm)
```

```cpp
#include <hip/hip_runtime.h>
#include <cstdio>
#include <cstdint>
#include <cmath>

#ifndef PROBE_DSA_SCALE
#define PROBE_DSA_SCALE 1.f
#endif
#ifndef PROBE_NSA_SCALE
#define PROBE_NSA_SCALE 1.f
#endif
#ifndef PROBE_REP_DSA
#define PROBE_REP_DSA 1
#endif
#ifndef PROBE_REP_NSA
#define PROBE_REP_NSA 1
#endif
#ifndef PROBE_REP_A
#define PROBE_REP_A 1
#endif
#ifndef PROBE_REP_C
#define PROBE_REP_C 1
#endif
#ifndef PROBE_REP_B
#define PROBE_REP_B 1
#endif
#ifndef MOE_CONV_SLACK
#define MOE_CONV_SLACK 1
#define MOE_CONV_ROUNDS 7
#endif
#ifndef PROBE_REP_MOE
#define PROBE_REP_MOE 1
#endif
#ifndef PROBE_REP_PRO
#define PROBE_REP_PRO 1
#endif
#ifndef ONLY_PHASE
#define ONLY_PHASE -1
#endif
#define PH_EN(k) (ONLY_PHASE < 0 || ONLY_PHASE == (k) || (ONLY_PHASE >= 100 && (k) >= ONLY_PHASE - 100 && (k) < ONLY_PHASE - 100 + 14))
#ifndef MK_SPLIT
#define MK_SPLIT 0
#endif

#define LAS __attribute__((address_space(3)))
#define GAS __attribute__((address_space(1)))
typedef unsigned short bf16_t;
typedef short bf16x8 __attribute__((ext_vector_type(8)));
typedef short s16x4 __attribute__((ext_vector_type(4)));
typedef float f32x2 __attribute__((ext_vector_type(2)));
typedef float f32x4 __attribute__((ext_vector_type(4)));
typedef float f32x16 __attribute__((ext_vector_type(16)));
typedef unsigned u32x2 __attribute__((ext_vector_type(2)));
typedef unsigned u32x4 __attribute__((ext_vector_type(4)));
typedef __bf16 bf16x2_t __attribute__((ext_vector_type(2)));
typedef short v4i16_t __attribute__((ext_vector_type(4)));

__device__ __forceinline__ unsigned cvtpk(float lo, float hi) { f32x2 v = {lo, hi}; bf16x2_t b = __builtin_convertvector(v, bf16x2_t); return __builtin_bit_cast(unsigned, b); }
#define WS_DPPF(v, ctrl, rmask) v += __int_as_float(__builtin_amdgcn_update_dpp(0, __float_as_int(v), ctrl, rmask, 0xF, false))
__device__ __forceinline__ float wave_sum(float v) {
    WS_DPPF(v, 0x111, 0xF); WS_DPPF(v, 0x112, 0xF); WS_DPPF(v, 0x114, 0xF); WS_DPPF(v, 0x118, 0xF); WS_DPPF(v, 0x142, 0xA); WS_DPPF(v, 0x143, 0xC);
    return __int_as_float(__builtin_amdgcn_readlane(__float_as_int(v), 63));
}
#undef WS_DPPF
__device__ __forceinline__ int wave_sum_i(int v) {
    v += __builtin_amdgcn_update_dpp(0, v, 0x111, 0xF, 0xF, false); v += __builtin_amdgcn_update_dpp(0, v, 0x112, 0xF, 0xF, false);
    v += __builtin_amdgcn_update_dpp(0, v, 0x114, 0xF, 0xF, false); v += __builtin_amdgcn_update_dpp(0, v, 0x118, 0xF, 0xF, false);
    v += __builtin_amdgcn_update_dpp(0, v, 0x142, 0xA, 0xF, false); v += __builtin_amdgcn_update_dpp(0, v, 0x143, 0xC, 0xF, false);
    return __builtin_amdgcn_readlane(v, 63);
}

__device__ __forceinline__ int wave_scan_incl_i(int v) {
    v += __builtin_amdgcn_update_dpp(0, v, 0x111, 0xF, 0xF, false); v += __builtin_amdgcn_update_dpp(0, v, 0x112, 0xF, 0xF, false);
    v += __builtin_amdgcn_update_dpp(0, v, 0x114, 0xF, 0xF, false); v += __builtin_amdgcn_update_dpp(0, v, 0x118, 0xF, 0xF, false);
    v += __builtin_amdgcn_update_dpp(0, v, 0x142, 0xA, 0xF, false); v += __builtin_amdgcn_update_dpp(0, v, 0x143, 0xC, 0xF, false);
    return v;
}
__device__ __forceinline__ int wave_total_i(int v) { return __builtin_amdgcn_readlane(wave_scan_incl_i(v), 63); }
__device__ __forceinline__ unsigned wave_max_u(unsigned v) {
    unsigned t;
    t = (unsigned)__builtin_amdgcn_update_dpp(0, (int)v, 0x111, 0xF, 0xF, false); v = t > v ? t : v; t = (unsigned)__builtin_amdgcn_update_dpp(0, (int)v, 0x112, 0xF, 0xF, false); v = t > v ? t : v;
    t = (unsigned)__builtin_amdgcn_update_dpp(0, (int)v, 0x114, 0xF, 0xF, false); v = t > v ? t : v; t = (unsigned)__builtin_amdgcn_update_dpp(0, (int)v, 0x118, 0xF, 0xF, false); v = t > v ? t : v;
    t = (unsigned)__builtin_amdgcn_update_dpp(0, (int)v, 0x142, 0xA, 0xF, false); v = t > v ? t : v; t = (unsigned)__builtin_amdgcn_update_dpp(0, (int)v, 0x143, 0xC, 0xF, false); v = t > v ? t : v;
    return (unsigned)__builtin_amdgcn_readlane((int)v, 63);
}
__device__ __forceinline__ float fast_exp2(float x) { return __builtin_amdgcn_exp2f(x); }
__device__ __forceinline__ float fast_rcp(float x) { return __builtin_amdgcn_rcpf(x); }
__device__ __forceinline__ float silu_f(float a) { return a * fast_rcp(1.f + fast_exp2(-1.4426950408889634f * a)); }
__device__ __forceinline__ float sigmoid_f(float a) { return fast_rcp(1.f + fast_exp2(-1.4426950408889634f * a)); }
__device__ __forceinline__ u32x4 ldg16(const void* p) { return *(const GAS u32x4*)p; }
__device__ __forceinline__ bf16x8 ldg16h(const void* p) { return *(const GAS bf16x8*)p; }
__device__ __forceinline__ f32x4 ldg16f(const void* p) { return *(const GAS f32x4*)p; }
__device__ __forceinline__ void stg16(void* p, u32x4 v) { *(GAS u32x4*)p = v; }
__device__ __forceinline__ void stg8(void* p, u32x2 v) { *(GAS u32x2*)p = v; }
__device__ __forceinline__ int rp16(int j) { return (j >> 1) + 8 * (j & 1); }

constexpr int T = 32768, S = 4096, D = 1024, NB = 8;
constexpr int FF = 2816, ED = 3584, NE = 8;
constexpr int DSA_IN = 472, NSA_IN = 2608;
constexpr float EPS = 1e-6f;
constexpr float C2 = 0.125f * 1.4426950408889634f;
constexpr float LOG2E = 1.4426950408889634f;

constexpr size_t MiB = 1u << 20;
constexpr size_t WS_CTL = 0, CTL_BYTES = 65536;
constexpr size_t WS_MOD = 1 * MiB;
constexpr size_t WS_ROPEC = 1 * MiB + 512 * 1024;
constexpr size_t WS_ROPES = 1 * MiB + 640 * 1024;
constexpr size_t WS_BIASKV = 1 * MiB + 768 * 1024;
constexpr size_t WS_WIN0 = 4 * MiB, WS_WQ = 5 * MiB, WS_WOC = 7 * MiB, WS_W13 = 11 * MiB, WS_W2 = 22 * MiB, WS_WNIN = 28 * MiB;
constexpr size_t WS_WK1 = 34 * MiB, WS_WV1 = 35 * MiB, WS_WK2V2 = 36 * MiB, WS_WNWO = 37 * MiB;
constexpr size_t WS_X = 40 * MiB;
constexpr size_t WS_H = 168 * MiB, WS_PROJ0 = 232 * MiB, WS_OLAT = 168 * MiB, WS_ONSA = 232 * MiB, WS_AMOE = 168 * MiB;
constexpr size_t WS_QLN = 296 * MiB, WS_KCAT = 312 * MiB, WS_IK = 322 * MiB, WS_IW = 326 * MiB, WS_QCAT = 328 * MiB, WS_IQ = 488 * MiB;
constexpr size_t WS_TMPQ = 396 * MiB, WS_TMPO = 400 * MiB;
constexpr size_t WS_U = 296 * MiB;
constexpr size_t WS_PROJ1 = 296 * MiB, WS_GATES = 472 * MiB, WS_CMPH = 478 * MiB, WS_KVCMP = 486 * MiB;
constexpr size_t WS_W13M = 300 * MiB, WS_W2M = 328 * MiB, WS_HID = 342 * MiB;
constexpr size_t W13M_BYTES = 14 * MiB, W2M_BYTES = 7 * MiB;
constexpr int CAPT = 48;
constexpr size_t HID_BYTES = (size_t)CAPT * 256 * ED * 2;
constexpr size_t WS_SLOTTOK = 510 * MiB, WS_SLOTGATE = 510 * MiB + 512 * 1024, WS_ROUTEE = 511 * MiB, WS_ROUTEG = 511 * MiB + 512 * 1024;
constexpr size_t WS_END = 520 * MiB;
static_assert(WS_HID + 2 * HID_BYTES <= WS_SLOTTOK, "ws map");
constexpr int AMOE_ROWS = 2 * T + NE * 256;
static_assert(WS_AMOE + (size_t)AMOE_ROWS * D * 2 <= WS_W13M, "ws map amoe");

constexpr int CW_BAR = 4096;
constexpr int CW_MOECNT = 8192;

constexpr int LDS_BYTES = 147456;
constexpr int LDS_MISC = 146432;

#define XB_TMO      128
#define XB_XCNT(j)  (256  + 64 * (j))
#define XB_XSUB(j)  (1280 + 64 * (j))
#define XB_XGEN(j)  (2304 + 64 * (j))
#define XB_TOP      3328
#define XB_TOPGEN   3392
#define XCD_BAR_WORDS 3456
#define XB_SPIN_CAP (1u << 22)

__device__ __forceinline__ unsigned xb_ld(unsigned* p)              { return __hip_atomic_load(p, __ATOMIC_RELAXED, __HIP_MEMORY_SCOPE_AGENT); }
__device__ __forceinline__ unsigned xb_add(unsigned* p, unsigned v) { return __hip_atomic_fetch_add(p, v, __ATOMIC_RELAXED, __HIP_MEMORY_SCOPE_AGENT); }
__device__ __forceinline__ unsigned xb_xcc_id() { return (unsigned)__builtin_amdgcn_s_getreg((3 << 11) | 20) & 0xFu; }
#define XB_SPIN(cond, bar) do { unsigned _sp = 0; while (cond) { __builtin_amdgcn_s_sleep(1); \
    if ((++_sp & 255u) == 0u) { if (xb_ld(&(bar)[XB_TMO])) break; if (_sp > XB_SPIN_CAP) { atomicAdd(&(bar)[XB_TMO], 1u); break; } } } } while (0)

struct XcdBarrier { unsigned* bar; unsigned x; volatile LAS unsigned* st; };

__device__ __forceinline__ XcdBarrier xcd_barrier_post(unsigned* bar, volatile LAS unsigned* st) {
    XcdBarrier b; b.bar = bar; b.x = xb_xcc_id(); b.st = st;
    if (threadIdx.x == 0) (void)xb_add(&bar[XB_XCNT(b.x)], 1u);
    return b;
}
__device__ __forceinline__ void xcd_barrier_complete(unsigned* bar, unsigned x, unsigned& nloc, unsigned& nx) {
    const unsigned G = gridDim.x * gridDim.y * gridDim.z;
    unsigned sum, cnt, mine, sp = 0u;
    for (;;) {
        sum = 0u; cnt = 0u; mine = 0u;
#pragma unroll
        for (unsigned j = 0; j < 16; ++j) { const unsigned c = xb_ld(&bar[XB_XCNT(j)]); sum += c; cnt += (c > 0u) ? 1u : 0u; mine = (j == x) ? c : mine; }
        if (sum == G) break;
        __builtin_amdgcn_s_sleep(1);
        if ((++sp & 255u) == 0u) { if (xb_ld(&bar[XB_TMO])) break; if (sp > XB_SPIN_CAP) { atomicAdd(&bar[XB_TMO], 1u); break; } }
    }
    nloc = mine > 0u ? mine : 1u; nx = cnt > 0u ? cnt : 1u;
}
__device__ __forceinline__ void xcd_barrier(const XcdBarrier& b, bool leader_thread) {
    asm volatile("s_waitcnt vmcnt(0)" ::: "memory");
    __syncthreads();
    if (leader_thread) {
        unsigned* bar = b.bar;
        __builtin_amdgcn_s_waitcnt(0);
        unsigned nloc = b.st[0], nx = b.st[1];
        if (nloc == 0u) { xcd_barrier_complete(bar, b.x, nloc, nx); b.st[0] = nloc; b.st[1] = nx; }
        const unsigned old = xb_add(&bar[XB_XSUB(b.x)], 1u);
        const unsigned gen = old / nloc;
        if (old + 1u == (gen + 1u) * nloc) {
            __builtin_amdgcn_fence(__ATOMIC_RELEASE, "agent");
            asm volatile("s_waitcnt vmcnt(0)" ::: "memory");
            const unsigned og = xb_add(&bar[XB_TOP], 1u);
            const unsigned tg = og / nx;
            if (og + 1u == (tg + 1u) * nx) xb_add(&bar[XB_TOPGEN], 1u);
            else XB_SPIN(xb_ld(&bar[XB_TOPGEN]) == tg, bar);
            __builtin_amdgcn_fence(__ATOMIC_ACQUIRE, "agent");
            xb_add(&bar[XB_XGEN(b.x)], 1u);
            asm volatile("s_waitcnt vmcnt(0)" ::: "memory");
        } else {
            XB_SPIN(xb_ld(&bar[XB_XGEN(b.x)]) == gen, bar);
            __builtin_amdgcn_fence(__ATOMIC_ACQUIRE, "agent");
            asm volatile("s_waitcnt vmcnt(0)" ::: "memory");
        }
    }
    __syncthreads();
}

namespace pg8 {
constexpr int BM = 256, BK = 64, HALF = 128, HTB = HALF * BK * 2, STAGE_BYTES = 8 * HTB, NXCD = 8, WGM = 8;
__host__ __device__ __forceinline__ int lds_byte(int r, int c) { const int st = (r >> 4) * 2 + (c >> 5), rr = r & 15, cc = c & 31, ob = rr * 64 + cc * 2; return st * 1024 + (ob ^ (((ob >> 9) & 1) << 5)); }
__host__ __device__ __forceinline__ void stage_rc(int b, int& R, int& C) { const int st = b / 1024, sb = b % 1024, swz = sb ^ (((sb >> 9) & 1) << 5); R = (st >> 1) * 16 + swz / 64; C = (st & 1) * 32 + (swz % 64) / 2; }
__host__ __device__ __forceinline__ int perm32(int rho) { const int n = rho >> 4, i = rho & 15; return 8 * (i >> 2) + 4 * n + (i & 3); }

struct Unit { int pm, pn; };
struct Gemm { const char* A; const char* Bt; int K; unsigned lda_bytes; unsigned kstepA; };
struct MapLinear { static __device__ __forceinline__ size_t rowoff(int r, unsigned ldb) { return (size_t)r * ldb; } };
struct MapCmp { static __device__ __forceinline__ size_t rowoff(int r, unsigned ldb) { return (size_t)(r >> 2) * 16 * ldb + (size_t)(r & 3) * 128; } };

struct StaticOrder {
    int nM, nN, nwg, G, c;
    __device__ void init(int nM_, int nN_, int G_, int c_) { nM = nM_; nN = nN_; nwg = nM * nN; G = G_; c = c_; }
    __device__ bool next(int i, Unit& u) const {
        const long L = (long)i * G + c; if (L >= nwg) return false;
        int wgid = (int)L; { const int q = nwg / NXCD, r = nwg % NXCD, xcd = wgid % NXCD, off = wgid / NXCD; wgid = (xcd < r ? xcd * (q + 1) : r * (q + 1) + (xcd - r) * q) + off; }
        const int nig = WGM * nN, gid = wgid / nig, fm = gid * WGM, gsz = (nM - fm) < WGM ? (nM - fm) : WGM;
        u.pm = fm + ((wgid % nig) % gsz); u.pn = (wgid % nig) / gsz; return true;
    }
};

struct ListOrder {
    int nN, total, first, nfirst, start2, stride2;
    __device__ bool next(int i, Unit& u) const {
        int L; if (i < nfirst) L = first + i; else L = start2 + (i - nfirst) * stride2;
        if (L >= total || (i >= nfirst && stride2 <= 0)) return false;
        u.pm = L / nN; u.pn = L - u.pm * nN; return true;
    }
};
template <class Epi, class AMap, class Sched = StaticOrder>
__device__ __forceinline__ void gemm_phase(LAS unsigned char* lds, const Gemm g, const Sched& S, const Epi& E, int tid_in) {
    int tid_ = tid_in; asm volatile("" : "+v"(tid_));
    const int tid = tid_, wid = __builtin_amdgcn_readfirstlane(tid >> 6), lane = tid & 63, wr = wid >> 2, wc = wid & 3, fr = lane & 15, fq = lane >> 4;
    const int K = g.K, nt = K / BK;
    unsigned voffA[2], voffB[2];
#pragma unroll
    for (int i = 0; i < 2; ++i) { int R, C; stage_rc(tid * 16 + i * 8192, R, C); const int Rb = Epi::PERM ? ((R & ~31) + perm32(R & 31)) : R;
        voffA[i] = (unsigned)AMap::rowoff(R, g.lda_bytes) + (unsigned)C * 2u; voffB[i] = (unsigned)(Rb * K + C) * 2u; }
    const size_t kstepA = g.kstepA, kstepB = (size_t)(BK * 2);
    const size_t hstepA = AMap::rowoff(HALF, g.lda_bytes), tstepA = AMap::rowoff(BM, g.lda_bytes);
    const size_t hstepB = (size_t)HALF * K * 2, tstepB = 2 * hstepB;
    const unsigned ldsw = (unsigned)wid * 1024u;
    const int aoff = lds_byte(wr * 64 + fr, fq * 8), boff = lds_byte(wc * 32 + fr, fq * 8);
#define PG8_SA(b, h) (((b) * 2 + (h)) * HTB)
#define PG8_SB(b, h) ((4 + (b) * 2 + (h)) * HTB)
#define PG8_STAGE(bufoff, gbase, voff) do { _Pragma("unroll") for (int _i = 0; _i < 2; ++_i) \
        __builtin_amdgcn_global_load_lds((const unsigned*)((const char*)(gbase) + (voff)[_i]), (LAS unsigned*)(lds + (bufoff) + ldsw + _i * 8192), 16, 0, 0); } while (0)
#define PG8_LDA(dst, b, h) do { _Pragma("unroll") for (int m = 0; m < 4; ++m) _Pragma("unroll") for (int k = 0; k < 2; ++k) dst[m][k] = *(const LAS bf16x8*)(lds + PG8_SA(b, h) + aoff + m * 2048 + k * 1024); } while (0)
#define PG8_LDB(dst, b, h) do { _Pragma("unroll") for (int n = 0; n < 2; ++n) _Pragma("unroll") for (int k = 0; k < 2; ++k) dst[n][k] = *(const LAS bf16x8*)(lds + PG8_SB(b, h) + boff + n * 2048 + k * 1024); } while (0)
#define PG8_MMA(ai, bj, At, Bt) do { __builtin_amdgcn_s_setprio(1); _Pragma("unroll") for (int m = 0; m < 4; ++m) _Pragma("unroll") for (int n = 0; n < 2; ++n) _Pragma("unroll") for (int k = 0; k < 2; ++k) \
        acc[ai][bj][m][n] = __builtin_amdgcn_mfma_f32_16x16x32_bf16(Bt[n][k], At[m][k], acc[ai][bj][m][n], 0, 0, 0); __builtin_amdgcn_s_setprio(0); } while (0)
#define PG8_WAIT_V(n) asm volatile("s_waitcnt vmcnt(" #n ")" ::: "memory")
#define PG8_WAIT_L(n) asm volatile("s_waitcnt lgkmcnt(" #n ")" ::: "memory")
#define PG8_BAR __builtin_amdgcn_s_barrier()
#define PG8_SCHED __builtin_amdgcn_sched_barrier(0)
    Unit cur, nxt; int ui = 0;
    if (!S.next(0, cur)) return;
    f32x4 acc[2][2][4][2];
#pragma unroll
    for (int a = 0; a < 2; ++a)
#pragma unroll
        for (int b = 0; b < 2; ++b)
#pragma unroll
            for (int m = 0; m < 4; ++m)
#pragma unroll
                for (int n = 0; n < 2; ++n) acc[a][b][m][n] = (f32x4){0.f, 0.f, 0.f, 0.f};
    bf16x8 At[4][2], B0[2][2], B1[2][2];
    const char* cA = g.A + (size_t)cur.pm * tstepA; const char* cB = g.Bt + (size_t)cur.pn * tstepB;
    PG8_STAGE(PG8_SB(0, 0), cB, voffB); PG8_STAGE(PG8_SB(0, 1), cB + hstepB, voffB); PG8_STAGE(PG8_SA(0, 0), cA, voffA); PG8_STAGE(PG8_SA(0, 1), cA + hstepA, voffA);
    if (wr == 1) PG8_BAR;
    PG8_WAIT_V(2); PG8_BAR;
    PG8_STAGE(PG8_SB(1, 0), cB + kstepB, voffB); PG8_STAGE(PG8_SA(1, 0), cA + kstepA, voffA); PG8_STAGE(PG8_SB(1, 1), cB + hstepB + kstepB, voffB);
    PG8_WAIT_V(6); PG8_BAR;
    for (;;) {
        const bool has_next = S.next(ui + 1, nxt);
        const char* nA = has_next ? g.A + (size_t)nxt.pm * tstepA : cA; const char* nB = has_next ? g.Bt + (size_t)nxt.pn * tstepB : cB;
#pragma nounroll
        for (int t = 0; t < nt; t += 2) {
            const bool last = (t == nt - 2);
            const char* a1 = cA + (size_t)(t + 1) * kstepA;
            const char* a2 = last ? nA : cA + (size_t)(t + 2) * kstepA; const char* b2 = last ? nB : cB + (size_t)(t + 2) * kstepB;
            const char* a3 = a2 + kstepA; const char* b3 = b2 + kstepB;
            PG8_LDB(B0, 0, 0); PG8_LDB(B1, 0, 1); PG8_SCHED; PG8_LDA(At, 0, 0); PG8_STAGE(PG8_SA(1, 1), a1 + hstepA, voffA);
            PG8_WAIT_V(8); PG8_WAIT_L(0); PG8_BAR; PG8_MMA(0, 0, At, B0); PG8_MMA(0, 1, At, B1); PG8_BAR; PG8_SCHED;
            PG8_LDA(At, 0, 1); PG8_STAGE(PG8_SB(0, 0), b2, voffB); PG8_STAGE(PG8_SB(0, 1), b2 + hstepB, voffB); PG8_STAGE(PG8_SA(0, 0), a2, voffA);
            PG8_WAIT_V(8); PG8_WAIT_L(0); PG8_BAR; PG8_MMA(1, 0, At, B0); PG8_MMA(1, 1, At, B1); PG8_BAR; PG8_SCHED;
            PG8_LDB(B0, 1, 0); PG8_LDB(B1, 1, 1); PG8_SCHED; PG8_LDA(At, 1, 0); PG8_STAGE(PG8_SA(0, 1), a2 + hstepA, voffA);
            PG8_WAIT_V(8); PG8_WAIT_L(0); PG8_BAR; PG8_MMA(0, 0, At, B0); PG8_MMA(0, 1, At, B1); PG8_BAR; PG8_SCHED;
            PG8_LDA(At, 1, 1); PG8_STAGE(PG8_SB(1, 0), b3, voffB); PG8_STAGE(PG8_SB(1, 1), b3 + hstepB, voffB); PG8_STAGE(PG8_SA(1, 0), a3, voffA);
            PG8_WAIT_V(8); PG8_WAIT_L(0); PG8_BAR; PG8_MMA(1, 0, At, B0); PG8_MMA(1, 1, At, B1); PG8_BAR; PG8_SCHED;
        }
        if (wr == 0) PG8_BAR;
        { int l2; asm volatile("v_mbcnt_lo_u32_b32 %0, -1, 0\n\tv_mbcnt_hi_u32_b32 %0, -1, %0" : "=v"(l2)); E(acc, cur, wr, wc, l2 & 15, l2 >> 4); }
        if (!has_next) break;
#pragma unroll
        for (int a = 0; a < 2; ++a)
#pragma unroll
            for (int b = 0; b < 2; ++b)
#pragma unroll
                for (int m = 0; m < 4; ++m)
#pragma unroll
                    for (int n = 0; n < 2; ++n) acc[a][b][m][n] = (f32x4){0.f, 0.f, 0.f, 0.f};
        cur = nxt; cA = nA; cB = nB; ++ui;
        if (wr == 1) PG8_BAR;
    }
    PG8_WAIT_V(0);
    PG8_BAR;
#undef PG8_SA
#undef PG8_SB
#undef PG8_STAGE
#undef PG8_LDA
#undef PG8_LDB
#undef PG8_MMA
#undef PG8_WAIT_V
#undef PG8_WAIT_L
#undef PG8_BAR
#undef PG8_SCHED
}

typedef const f32x4 (&AccT)[2][2][4][2];

struct EpiF32 {
    static constexpr bool PERM = false;
    float* C; int ldc;
    __device__ __forceinline__ void operator()(AccT acc, const Unit& u, int wr, int wc, int fr, int fq) const {
        const int row0 = u.pm * BM + wr * 64 + fr, col0 = u.pn * BM + wc * 32 + 4 * fq;
#pragma unroll
        for (int ai = 0; ai < 2; ++ai)
#pragma unroll
            for (int m = 0; m < 4; ++m) { float* rowp = C + (size_t)(row0 + ai * HALF + m * 16) * ldc + col0;
#pragma unroll
                for (int bj = 0; bj < 2; ++bj)
#pragma unroll
                    for (int n = 0; n < 2; ++n) *(f32x4*)(rowp + bj * HALF + n * 16) = acc[ai][bj][m][n]; }
    }
};
struct EpiResid {
    static constexpr bool PERM = false;
    const float* Xin; float* Xout; const float* gate; float pscale;
    __device__ __forceinline__ void operator()(AccT acc, const Unit& u, int wr, int wc, int fr, int fq) const {
        const int row0 = u.pm * BM + wr * 64 + fr, col0 = u.pn * BM + wc * 32 + 4 * fq;
        const float* gp = gate + (size_t)((u.pm * BM) >> 12) * 3072 + col0;
        f32x4 gv[2][2];
#pragma unroll
        for (int bj = 0; bj < 2; ++bj)
#pragma unroll
            for (int n = 0; n < 2; ++n) gv[bj][n] = *(const f32x4*)(gp + bj * HALF + n * 16);
#pragma unroll
        for (int ai = 0; ai < 2; ++ai)
#pragma unroll
            for (int m = 0; m < 4; ++m) { const size_t ro = (size_t)(row0 + ai * HALF + m * 16) * D + col0;
#pragma unroll
                for (int bj = 0; bj < 2; ++bj)
#pragma unroll
                    for (int n = 0; n < 2; ++n) { const f32x4 xv = *(const f32x4*)(Xin + ro + bj * HALF + n * 16);
                        *(f32x4*)(Xout + ro + bj * HALF + n * 16) = xv + (gv[bj][n] * pscale) * acc[ai][bj][m][n]; }
                asm volatile("" ::: "memory"); }
    }
};
struct EpiSwiglu {
    static constexpr bool PERM = true;
    bf16_t* O; int ldo;
    __device__ __forceinline__ void operator()(AccT acc, const Unit& u, int wr, int wc, int fr, int fq) const {
        const int row0 = u.pm * BM + wr * 64 + fr, col0 = u.pn * HALF + wc * 32 + 8 * fq;
#pragma unroll
        for (int ai = 0; ai < 2; ++ai)
#pragma unroll
            for (int m = 0; m < 4; ++m) { bf16_t* rowp = O + (size_t)(row0 + ai * HALF + m * 16) * ldo + col0;
                const f32x4 a0 = acc[ai][0][m][0], a1 = acc[ai][0][m][1], b0 = acc[ai][1][m][0], b1 = acc[ai][1][m][1];
                u32x4 w;
                w.x = cvtpk(silu_f(a0[0]) * b0[0], silu_f(a0[1]) * b0[1]); w.y = cvtpk(silu_f(a0[2]) * b0[2], silu_f(a0[3]) * b0[3]);
                w.z = cvtpk(silu_f(a1[0]) * b1[0], silu_f(a1[1]) * b1[1]); w.w = cvtpk(silu_f(a1[2]) * b1[2], silu_f(a1[3]) * b1[3]);
                *(u32x4*)rowp = w; asm volatile("" ::: "memory"); }
    }
};
__device__ __forceinline__ void rope8(f32x4& v0, f32x4& v1, const float* rc, const float* rs, int pos, int j0) {
    const f32x4 c = *(const f32x4*)(rc + pos * 8 + j0), s = *(const f32x4*)(rs + pos * 8 + j0);
    f32x4 o0, o1;
    o0[0] = v0[0] * c[0] - v0[1] * s[0]; o0[1] = v0[1] * c[0] + v0[0] * s[0];
    o0[2] = v0[2] * c[1] - v0[3] * s[1]; o0[3] = v0[3] * c[1] + v0[2] * s[1];
    o1[0] = v1[0] * c[2] - v1[1] * s[2]; o1[1] = v1[1] * c[2] + v1[0] * s[2];
    o1[2] = v1[2] * c[3] - v1[3] * s[3]; o1[3] = v1[3] * c[3] + v1[2] * s[3];
    v0 = o0; v1 = o1;
}
template <bool ISQ> struct EpiQ {
    static constexpr bool PERM = true;
    bf16_t* O; const float* rc; const float* rs;
    __device__ __forceinline__ void operator()(AccT acc, const Unit& u, int wr, int wc, int fr, int fq) const {
        const int row0 = u.pm * BM + wr * 64 + fr;
        constexpr int ld = ISQ ? 2560 : 512; constexpr float sc = ISQ ? 0.125f : 1.f;
#pragma unroll
        for (int bj = 0; bj < 2; ++bj) {
            const int cc = u.pn * BM + bj * HALF + wc * 32 + 8 * fq;
            const int blk = ISQ ? (cc % 160) : (cc & 63);
            const bool rope = blk < 16;
#pragma unroll
            for (int ai = 0; ai < 2; ++ai)
#pragma unroll
                for (int m = 0; m < 4; ++m) { const int r = row0 + ai * HALF + m * 16;
                    f32x4 v0 = acc[ai][bj][m][0], v1 = acc[ai][bj][m][1];
                    if (rope) rope8(v0, v1, rc, rs, r & (S - 1), blk >> 1);
                    v0 = v0 * sc; v1 = v1 * sc;
                    u32x4 w; w.x = cvtpk(v0[0], v0[1]); w.y = cvtpk(v0[2], v0[3]); w.z = cvtpk(v1[0], v1[1]); w.w = cvtpk(v1[2], v1[3]);
                    *(u32x4*)(O + (size_t)r * ld + cc) = w; asm volatile("" ::: "memory"); }
        }
    }
};
struct EpiNsaIn {
    static constexpr bool PERM = true;
    bf16_t* P1; float* GATES; const float* rc; const float* rs;
    __device__ __forceinline__ void operator()(AccT acc, const Unit& u, int wr, int wc, int fr, int fq) const {
        const int row0 = u.pm * BM + wr * 64 + fr;
#pragma unroll
        for (int bj = 0; bj < 2; ++bj) {
            const int gc = u.pn * BM + bj * HALF + wc * 32 + 8 * fq;
            if (gc >= 2560) {
                if (gc < NSA_IN) {
#pragma unroll
                    for (int ai = 0; ai < 2; ++ai)
#pragma unroll
                        for (int m = 0; m < 4; ++m) { const int r = row0 + ai * HALF + m * 16; const f32x4 v0 = acc[ai][bj][m][0], v1 = acc[ai][bj][m][1];
                            float* gp = GATES + (size_t)r * 48 + (gc - 2560);
                            *(f32x4*)gp = (f32x4){sigmoid_f(v0[0]), sigmoid_f(v0[1]), sigmoid_f(v0[2]), sigmoid_f(v0[3])};
                            *(f32x4*)(gp + 4) = (f32x4){sigmoid_f(v1[0]), sigmoid_f(v1[1]), sigmoid_f(v1[2]), sigmoid_f(v1[3])}; asm volatile("" ::: "memory"); }
                }
                continue;
            }
            const bool isq = gc < 1024; const int reg = (gc - 1024) >> 8;
            const bool rope = ((gc & 63) < 16) && (isq || ((reg & 1) == 0));
            const float sc = isq ? C2 : 1.f;
#pragma unroll
            for (int ai = 0; ai < 2; ++ai)
#pragma unroll
                for (int m = 0; m < 4; ++m) { const int r = row0 + ai * HALF + m * 16;
                    f32x4 v0 = acc[ai][bj][m][0], v1 = acc[ai][bj][m][1];
                    if (rope) rope8(v0, v1, rc, rs, r & (S - 1), (gc & 63) >> 1);
                    v0 = v0 * sc; v1 = v1 * sc;
                    u32x4 w; w.x = cvtpk(v0[0], v0[1]); w.y = cvtpk(v0[2], v0[3]); w.z = cvtpk(v1[0], v1[1]); w.w = cvtpk(v1[2], v1[3]);
                    *(u32x4*)(P1 + (size_t)r * FF + gc) = w; asm volatile("" ::: "memory"); }
        }
    }
};
struct EpiNsaGate {
    static constexpr bool PERM = true;
    float* GATES;
    __device__ __forceinline__ void operator()(AccT acc, const Unit& u, int wr, int wc, int fr, int fq) const {
        const int row0 = u.pm * BM + wr * 64 + fr; const int gc = 2560 + wc * 32 + 8 * fq;
        if (gc < NSA_IN) {
#pragma unroll
            for (int ai = 0; ai < 2; ++ai)
#pragma unroll
                for (int m = 0; m < 4; ++m) { const int r = row0 + ai * HALF + m * 16; const f32x4 v0 = acc[ai][0][m][0], v1 = acc[ai][0][m][1];
                    float* gp = GATES + (size_t)r * 48 + (gc - 2560);
                    *(f32x4*)gp = (f32x4){sigmoid_f(v0[0]), sigmoid_f(v0[1]), sigmoid_f(v0[2]), sigmoid_f(v0[3])};
                    *(f32x4*)(gp + 4) = (f32x4){sigmoid_f(v1[0]), sigmoid_f(v1[1]), sigmoid_f(v1[2]), sigmoid_f(v1[3])}; asm volatile("" ::: "memory"); }
        }
    }
};
struct EpiCmpH {
    static constexpr bool PERM = true;
    bf16_t* O; const float* bias; int coloff;
    __device__ __forceinline__ void operator()(AccT acc, const Unit& u, int wr, int wc, int fr, int fq) const {
        const int row0 = u.pm * BM + wr * 64 + fr;
#pragma unroll
        for (int bj = 0; bj < 2; ++bj) { const int c = bj * HALF + wc * 32 + 8 * fq;
            const f32x4 bv0 = *(const f32x4*)(bias + c), bv1 = *(const f32x4*)(bias + c + 4);
#pragma unroll
            for (int ai = 0; ai < 2; ++ai)
#pragma unroll
                for (int m = 0; m < 4; ++m) { const int r = row0 + ai * HALF + m * 16;
                    const f32x4 v0 = acc[ai][bj][m][0] + bv0, v1 = acc[ai][bj][m][1] + bv1;
                    u32x4 w; w.x = cvtpk(silu_f(v0[0]), silu_f(v0[1])); w.y = cvtpk(silu_f(v0[2]), silu_f(v0[3])); w.z = cvtpk(silu_f(v1[0]), silu_f(v1[1])); w.w = cvtpk(silu_f(v1[2]), silu_f(v1[3]));
                    *(u32x4*)(O + (size_t)r * 512 + coloff + c) = w; asm volatile("" ::: "memory"); } }
    }
};
struct EpiCmpO {
    static constexpr bool PERM = true;
    bf16_t* O;
    __device__ __forceinline__ void operator()(AccT acc, const Unit& u, int wr, int wc, int fr, int fq) const {
        const int row0 = u.pm * BM + wr * 64 + fr; const int c = wc * 32 + 8 * fq;
#pragma unroll
        for (int ai = 0; ai < 2; ++ai)
#pragma unroll
            for (int m = 0; m < 4; ++m) { const int r = row0 + ai * HALF + m * 16;
                const f32x4 v0 = acc[ai][0][m][0], v1 = acc[ai][0][m][1];
                u32x4 w; w.x = cvtpk(v0[0], v0[1]); w.y = cvtpk(v0[2], v0[3]); w.z = cvtpk(v1[0], v1[1]); w.w = cvtpk(v1[2], v1[3]);
                *(u32x4*)(O + (size_t)r * 128 + c) = w; }
    }
};
struct EpiMoeDown {
    static constexpr bool PERM = false;
    float* X; const float* gate; const int* slot_tok; const float* slot_gate; int row0s; float pscale;
    __device__ __forceinline__ void operator()(AccT acc, const Unit& u, int wr, int wc, int fr, int fq) const {
        const int row0 = u.pm * BM + wr * 64 + fr, col0 = u.pn * BM + wc * 32 + 4 * fq;
#pragma unroll
        for (int ai = 0; ai < 2; ++ai)
#pragma unroll
            for (int m = 0; m < 4; ++m) { const int sr = row0s + row0 + ai * HALF + m * 16; const int tok = slot_tok[sr];
                if (tok >= 0) { const float gg = slot_gate[sr] * pscale; const float* gp = gate + (size_t)(tok >> 12) * 3072 + col0; float* xp = X + (size_t)tok * D + col0;
#pragma unroll
                    for (int bj = 0; bj < 2; ++bj)
#pragma unroll
                        for (int n = 0; n < 2; ++n) { const f32x4 gv = *(const f32x4*)(gp + bj * HALF + n * 16); const f32x4 xv = *(const f32x4*)(xp + bj * HALF + n * 16);
                            *(f32x4*)(xp + bj * HALF + n * 16) = xv + (gv * gg) * acc[ai][bj][m][n]; } }
                asm volatile("" ::: "memory"); }
    }
};
}

struct Args { const float* in[29]; float* out; unsigned char* ws; int ph_lo, ph_hi; };
enum { I_X = 0, I_C, I_NORM_MIX, I_NORM_FFN, I_ADA_W, I_ADA_B, I_FINAL_NORM, I_DSA_W_IN, I_DSA_G_Q, I_DSA_W_UQ, I_DSA_G_KV, I_DSA_W_UK, I_DSA_W_UV, I_DSA_W_IQ, I_DSA_W_O,
       I_FFN_W1, I_FFN_W3, I_FFN_W2, I_NSA_W_IN, I_NSA_CMP_PE, I_NSA_CMP_K1, I_NSA_CMP_K2, I_NSA_CMP_V1, I_NSA_CMP_V2, I_NSA_W_O, I_MOE_ROUTER, I_MOE_W1, I_MOE_W3, I_MOE_W2 };

template <class F>
__device__ __forceinline__ void conv_one(const F& f, int N, int K, bf16_t* WT, LAS float* scr, int it, int lane) {
    const int nblk = N / 32; const int kb = it / nblk, nb = it % nblk, k0 = 64 * kb, n0 = 32 * nb;
    float tv[32];
#pragma unroll
    for (int i = 0; i < 32; ++i) tv[i] = f(k0 + 2 * i + (lane >> 5), n0 + (lane & 31));
#pragma unroll
    for (int i = 0; i < 32; ++i) { const int kk = 2 * i + (lane >> 5); scr[kk * 33 + (lane & 31)] = tv[i]; }
    asm volatile("s_waitcnt lgkmcnt(0)" ::: "memory");
    const int c = lane & 7;
#pragma unroll
    for (int j = 0; j < 4; ++j) { const int n = (lane >> 3) + 8 * j; const LAS float* s = scr + (8 * c) * 33 + n;
        u32x4 o; o.x = cvtpk(s[0 * 33], s[1 * 33]); o.y = cvtpk(s[2 * 33], s[3 * 33]); o.z = cvtpk(s[4 * 33], s[5 * 33]); o.w = cvtpk(s[6 * 33], s[7 * 33]);
        *(u32x4*)(WT + (size_t)(n0 + n) * K + k0 + 8 * c) = o; }
    asm volatile("s_waitcnt lgkmcnt(0)" ::: "memory");
}
template <class F>
__device__ __forceinline__ void conv_items(const F& f, int N, int K, bf16_t* WT, LAS float* scr, int gw, int NGW, int lane) {
    const int nitems = (N / 32) * (K / 64);
    for (int it = gw; it < nitems; it += NGW) conv_one(f, N, K, WT, scr, it, lane);
}
template <class F>
__device__ __forceinline__ void conv_range(const F& f, int N, int K, bf16_t* WT, LAS float* scr, int it0, int it1, int gw, int NGW, int lane) {
    for (int it = it0 + gw; it < it1; it += NGW) conv_one(f, N, K, WT, scr, it, lane);
}
struct FPlain { const float* W; int ldw; __device__ __forceinline__ float operator()(int k, int n) const { return W[(size_t)k * ldw + n]; } };
struct FIn0 { const float* W; __device__ __forceinline__ float operator()(int k, int n) const { return n < DSA_IN ? W[(size_t)k * DSA_IN + n] : 0.f; } };
struct F13 { const float* W1; const float* W3; int ff;
    __device__ __forceinline__ float operator()(int k, int n) const { const int t = n >> 8, bj = (n >> 7) & 1, j = n & 127;
        const long long delta = (const char*)W3 - (const char*)W1;
        const float* w = (const float*)((const char*)W1 + (long long)bj * delta); return w[(size_t)k * ff + t * 128 + j]; } };
struct FNin { const float* W;
    __device__ __forceinline__ float operator()(int k, int n) const {
        if (n >= NSA_IN) return 0.f;
        int src = n;
        if (n < 2560) { const bool isq = n < 1024; const int reg = (n - 1024) >> 8; const int j = n & 63;
            if (j < 16 && (isq || ((reg & 1) == 0))) src = (n & ~63) + rp16(j); }
        return W[(size_t)k * NSA_IN + src]; } };
struct FK1 { const float* W;
    __device__ __forceinline__ float operator()(int k, int n) const { const int d = k & 63; const int ks = d < 16 ? (k & ~63) + rp16(d) : k; return W[(size_t)ks * 256 + n]; } };
struct FK2V2 { const float* K2; const float* V2;
    __device__ __forceinline__ float operator()(int k, int n) const {
        if (n < 64) return k < 256 ? K2[(size_t)k * 64 + n] : 0.f;
        if (n < 128) return k >= 256 ? V2[(size_t)(k - 256) * 64 + (n - 64)] : 0.f;
        return 0.f; } };
struct FQ { const float* Wuq; const float* Wiq; const float* TMPQ;
    __device__ __forceinline__ float operator()(int k, int n) const {
        if (n < 2560) { const int h = n / 160, j = n - h * 160;
            if (j < 16) return Wuq[(size_t)k * 1024 + h * 64 + rp16(j)];
            if (j < 144) return TMPQ[(size_t)k * 2048 + h * 128 + (j - 16)];
            return 0.f; }
        const int m = n - 2560, j = m & 63; const int src = (m & ~63) + (j < 16 ? rp16(j) : j);
        return Wiq[(size_t)k * 512 + src]; } };

template <int NBV>
__device__ __forceinline__ void gemv_item(const LAS float* act, const float* W, int ldw, int K, int n0, const float* bias, float* out, int out_stride, LAS float* red, int wave, int lane) {
    const int kc = K / 8, k0 = wave * kc;
    float acc[NBV];
#pragma unroll
    for (int b = 0; b < NBV; ++b) acc[b] = 0.f;
    for (int k = k0; k < k0 + kc; k += 16) {
        float w[16];
#pragma unroll
        for (int i = 0; i < 16; ++i) w[i] = *(const GAS float*)(W + (size_t)(k + i) * ldw + n0 + lane);
#pragma unroll
        for (int b = 0; b < NBV; ++b) {
#pragma unroll
            for (int i4 = 0; i4 < 4; ++i4) { const f32x4 a = *(const LAS f32x4*)(act + b * K + k + 4 * i4);
                acc[b] += a[0] * w[4 * i4] + a[1] * w[4 * i4 + 1] + a[2] * w[4 * i4 + 2] + a[3] * w[4 * i4 + 3]; } }
    }
#pragma unroll
    for (int b = 0; b < NBV; ++b) red[(wave * NBV + b) * 64 + lane] = acc[b];
    __syncthreads();
    for (int b = wave; b < NBV; b += 8) { float s = 0.f;
#pragma unroll
        for (int w = 0; w < 8; ++w) s += red[(w * NBV + b) * 64 + lane];
        out[(size_t)b * out_stride + n0 + lane] = s + (bias ? bias[n0 + lane] : 0.f); }
    __syncthreads();
}

__device__ __forceinline__ void mod_row(const float* xrow, const float* g, const float* modb, bf16_t* orow, int lane) {
    f32x4 v[4]; float ss = 0.f;
#pragma unroll
    for (int j = 0; j < 4; ++j) { v[j] = *(const f32x4*)(xrow + 4 * lane + 256 * j); ss += (v[j][0] * v[j][0] + v[j][1] * v[j][1]) + (v[j][2] * v[j][2] + v[j][3] * v[j][3]); }
    const float r = 1.f / sqrtf(wave_sum(ss) * (1.f / D) + EPS);
#pragma unroll
    for (int j = 0; j < 4; ++j) { const int c = 4 * lane + 256 * j;
        const f32x4 gv = *(const f32x4*)(g + c), sh = *(const f32x4*)(modb + c), sc = *(const f32x4*)(modb + D + c);
        const f32x4 y = (v[j] * r) * gv * (sc + 1.f) + sh;
        u32x2 o; o.x = cvtpk(y[0], y[1]); o.y = cvtpk(y[2], y[3]);
        *(u32x2*)(orow + c) = o; }
}
__device__ __forceinline__ void mod_rows(const float* X, const float* g, const float* mod, bf16_t* H, int gw, int NGW, int lane) {
    for (int m = gw; m < T; m += 2 * NGW) {
        const int m2 = m + NGW;
        f32x4 va[4], vb[4]; float sa = 0.f, sb = 0.f;
#pragma unroll
        for (int j = 0; j < 4; ++j) va[j] = ldg16f(X + (size_t)m * D + 4 * lane + 256 * j);
        if (m2 < T) {
#pragma unroll
            for (int j = 0; j < 4; ++j) vb[j] = ldg16f(X + (size_t)m2 * D + 4 * lane + 256 * j); }
#pragma unroll
        for (int j = 0; j < 4; ++j) sa += (va[j][0] * va[j][0] + va[j][1] * va[j][1]) + (va[j][2] * va[j][2] + va[j][3] * va[j][3]);
        const float ra = 1.f / sqrtf(wave_sum(sa) * (1.f / D) + EPS);
        { const float* modb = mod + (size_t)(m >> 12) * 3072;
#pragma unroll
          for (int j = 0; j < 4; ++j) { const int c = 4 * lane + 256 * j;
            const f32x4 gv = *(const f32x4*)(g + c), sh = *(const f32x4*)(modb + c), sc = *(const f32x4*)(modb + D + c);
            const f32x4 y = (va[j] * ra) * gv * (sc + 1.f) + sh;
            u32x2 o; o.x = cvtpk(y[0], y[1]); o.y = cvtpk(y[2], y[3]); stg8(H + (size_t)m * D + c, o); } }
        if (m2 < T) {
#pragma unroll
            for (int j = 0; j < 4; ++j) sb += (vb[j][0] * vb[j][0] + vb[j][1] * vb[j][1]) + (vb[j][2] * vb[j][2] + vb[j][3] * vb[j][3]);
            const float rb = 1.f / sqrtf(wave_sum(sb) * (1.f / D) + EPS);
            const float* modb = mod + (size_t)(m2 >> 12) * 3072;
#pragma unroll
            for (int j = 0; j < 4; ++j) { const int c = 4 * lane + 256 * j;
                const f32x4 gv = *(const f32x4*)(g + c), sh = *(const f32x4*)(modb + c), sc = *(const f32x4*)(modb + D + c);
                const f32x4 y = (vb[j] * rb) * gv * (sc + 1.f) + sh;
                u32x2 o; o.x = cvtpk(y[0], y[1]); o.y = cvtpk(y[2], y[3]); stg8(H + (size_t)m2 * D + c, o); } }
    }
}
__device__ __forceinline__ void dsa_post_rows(const float* P0, const float* gq, const float* gkv, const float* rc, const float* rs,
                                              bf16_t* QLN, bf16_t* KCAT, bf16_t* IK, float* IW, int gw, int NGW, int lane) {
    f32x4 an, bn;
    { const int m0 = gw < T ? gw : T - 1; an = ldg16f(P0 + (size_t)m0 * 512 + 4 * lane); bn = ldg16f(P0 + (size_t)m0 * 512 + 256 + 4 * lane); }
    for (int m = gw; m < T; m += NGW) {
        const int pos = m & (S - 1);
        const f32x4 a = an, b = bn;
        { const int mn = (m + NGW < T) ? m + NGW : m; an = ldg16f(P0 + (size_t)mn * 512 + 4 * lane); bn = ldg16f(P0 + (size_t)mn * 512 + 256 + 4 * lane); }
        const float ssq = wave_sum((a[0] * a[0] + a[1] * a[1]) + (a[2] * a[2] + a[3] * a[3]));
        const float sb = (b[0] * b[0] + b[1] * b[1]) + (b[2] * b[2] + b[3] * b[3]);
        const float sskv = wave_sum(lane < 32 ? sb : 0.f);
        const float rq = 1.f / sqrtf(ssq * (1.f / 256.f) + EPS), rkv = 1.f / sqrtf(sskv * (1.f / 128.f) + EPS);
        { const f32x4 gv = *(const f32x4*)(gq + 4 * lane); const f32x4 y = a * rq * gv; u32x2 o; o.x = cvtpk(y[0], y[1]); o.y = cvtpk(y[2], y[3]); *(u32x2*)(QLN + (size_t)m * 256 + 4 * lane) = o; }
        f32x4 p;
#pragma unroll
        for (int e = 0; e < 4; ++e) { const float be = b[e]; p[e] = __int_as_float(__builtin_amdgcn_update_dpp(0, __float_as_int(be), 0x4E, 0xF, 0xF, true)); }
        if (lane < 32) { const f32x4 gv = *(const f32x4*)(gkv + 4 * lane); const f32x4 y = b * rkv * gv; u32x2 o; o.x = cvtpk(y[0], y[1]); o.y = cvtpk(y[2], y[3]);
            *(u32x2*)(KCAT + (size_t)m * 160 + 16 + 4 * lane) = o; }
        else if (lane == 32 || lane == 33 || lane == 36 || lane == 37) {
            const int j0 = 4 * (lane & 1);
            const f32x4 c = *(const f32x4*)(rc + pos * 8 + j0), s = *(const f32x4*)(rs + pos * 8 + j0);
            u32x4 o;
            o.x = cvtpk(b[0] * c[0] - p[0] * s[0], p[0] * c[0] + b[0] * s[0]); o.y = cvtpk(b[1] * c[1] - p[1] * s[1], p[1] * c[1] + b[1] * s[1]);
            o.z = cvtpk(b[2] * c[2] - p[2] * s[2], p[2] * c[2] + b[2] * s[2]); o.w = cvtpk(b[3] * c[3] - p[3] * s[3], p[3] * c[3] + b[3] * s[3]);
            bf16_t* dst = (lane < 36) ? KCAT + (size_t)m * 160 + 8 * (lane & 1) : IK + (size_t)m * 64 + 8 * (lane & 1);
            *(u32x4*)dst = o; }
        else if (lane >= 40 && lane < 52) { u32x2 o; o.x = cvtpk(b[0], b[1]); o.y = cvtpk(b[2], b[3]); *(u32x2*)(IK + (size_t)m * 64 + 16 + 4 * (lane - 40)) = o; }
        else if (lane == 52 || lane == 53) { const float sc = 0.35355339059327379f * 0.125f; *(f32x4*)(IW + (size_t)m * 8 + 4 * (lane - 52)) = b * sc; }
        else if (lane == 54 || lane == 55) { *(u32x4*)(KCAT + (size_t)m * 160 + 144 + 8 * (lane - 54)) = (u32x4){0u, 0u, 0u, 0u}; }
    }
}

constexpr int DSA_SEL_OFF = 131072, DSA_HIST_OFF = 135168;
static_assert(DSA_HIST_OFF + 8 * 1024 <= LDS_MISC, "DSA LDS map");
__device__ __forceinline__ s16x4 lds_tr16(const LAS unsigned char* p) { return __builtin_bit_cast(s16x4, __builtin_amdgcn_ds_read_tr16_b64_v4i16((LAS v4i16_t*)p)); }
__device__ __forceinline__ int mbcnt64(unsigned long long m) { return (int)__builtin_amdgcn_mbcnt_hi((unsigned)(m >> 32), __builtin_amdgcn_mbcnt_lo((unsigned)m, 0u)); }

__device__ __forceinline__ void dsa_core(const bf16_t* IQ, const bf16_t* IK, const float* IW, const bf16_t* QCAT, const bf16_t* KCAT, bf16_t* OLAT,
                                         LAS unsigned char* lds, int bid, int G, int wave, int lane0) {
#define DSA_LV int lane_ = lane0; asm volatile("" : "+v"(lane_)); const int lane = lane_;
    LAS float* scores = (LAS float*)lds;
    for (int u = bid; u < 4096; u += G) {
        const int b = u & 7, tr = u >> 3, ii = tr >> 5, ss = tr & 31;
        const int tile = (ii & 1) ? (ii * 32 + 31 - ss) : (ii * 32 + ss);
        const int t0 = tile * 8; const size_t tokbase = (size_t)b * S + t0;
        for (int repa = 0; repa < PROBE_REP_A; ++repa)
        {   DSA_LV
            const int r = lane & 31, h = lane >> 5; const int g_ = r >> 3, hi_ = (r >> 2) & 1, jp = r & 3;
            bf16x8 af[2][4]; f32x4 wv[2][4];
            const int nk32 = (t0 + 8 + 31) >> 5;
            const bf16_t* ikp = IK + ((size_t)b * S + r) * 64 + 8 * h;
            bf16x8 bq[4][4];
#define DSA_LDB(slot, cc) do { const int cl_ = (cc) < nk32 ? (cc) : nk32 - 1; const bf16_t* p_ = ikp + (size_t)cl_ * 32 * 64; \
        asm volatile("global_load_dwordx4 %0, %4, off\n\tglobal_load_dwordx4 %1, %4, off offset:32\n\tglobal_load_dwordx4 %2, %4, off offset:64\n\tglobal_load_dwordx4 %3, %4, off offset:96" \
            : "=&v"(bq[slot][0]), "=&v"(bq[slot][1]), "=&v"(bq[slot][2]), "=&v"(bq[slot][3]) : "v"(p_) : "memory"); } while (0)
#define DSA_WAITB(slot, n) asm volatile("s_waitcnt vmcnt(" #n ")" : "+v"(bq[slot][0]), "+v"(bq[slot][1]), "+v"(bq[slot][2]), "+v"(bq[slot][3]) :: "memory")
            DSA_LDB(0, wave); DSA_LDB(1, wave + 8); DSA_LDB(2, wave + 16);
#pragma unroll
            for (int rb = 0; rb < 2; ++rb) { const int q = 4 * rb + 2 * hi_ + (g_ >> 1), head = 4 * (g_ & 1) + jp;
#pragma unroll
                for (int ks = 0; ks < 4; ++ks) af[rb][ks] = ldg16h(IQ + (tokbase + q) * 512 + head * 64 + 16 * ks + 8 * h);
#pragma unroll
                for (int g = 0; g < 4; ++g) wv[rb][g] = ldg16f(IW + (tokbase + 4 * rb + 2 * h + (g >> 1)) * 8 + 4 * (g & 1)); }
            asm volatile("" :: "v"(af[0][0]), "v"(af[0][1]), "v"(af[0][2]), "v"(af[0][3]), "v"(af[1][0]), "v"(af[1][1]), "v"(af[1][2]), "v"(af[1][3]),
                               "v"(wv[0][0]), "v"(wv[0][1]), "v"(wv[0][2]), "v"(wv[0][3]), "v"(wv[1][0]), "v"(wv[1][1]), "v"(wv[1][2]), "v"(wv[1][3]) : "memory");
            for (int c = wave; c < nk32; c += 32) {
#pragma unroll
                for (int uu = 0; uu < 4; ++uu) {
                    const int cc = c + 8 * uu;
                    DSA_LDB((uu + 3) & 3, cc + 24);
                    DSA_WAITB(uu, 12);
                    if (cc < nk32) {
                        const int key = 32 * cc + r;
#pragma unroll
                        for (int rb = 0; rb < 2; ++rb) {
                            f32x16 acc = {};
#pragma unroll
                            for (int ks = 0; ks < 4; ++ks) acc = __builtin_amdgcn_mfma_f32_32x32x16_bf16(af[rb][ks], bq[uu][ks], acc, 0, 0, 0);
                            float s0 = 0.f, s1 = 0.f;
#pragma unroll
                            for (int g = 0; g < 2; ++g)
#pragma unroll
                                for (int j = 0; j < 4; ++j) {
                                    const float a0_ = acc[4 * g + j], a1_ = acc[8 + 4 * g + j];
                                    const int i0 = __float_as_int(a0_), i1 = __float_as_int(a1_);
                                    s0 += __int_as_float(i0 > 0 ? i0 : 0) * wv[rb][g][j]; s1 += __int_as_float(i1 > 0 ? i1 : 0) * wv[rb][2 + g][j]; }
                            const int qa = 4 * rb + 2 * h;
                            scores[qa * 4096 + key] = s0 + 0.f; scores[(qa + 1) * 4096 + key] = s1 + 0.f;
                        }
                    }
                }
            }
            __syncthreads();
            DSA_WAITB(0, 0); DSA_WAITB(1, 0); DSA_WAITB(2, 0); DSA_WAITB(3, 0);
#undef DSA_LDB
#undef DSA_WAITB
        }
        const int t = t0 + wave;
        bf16x8 qf[5];
        {   DSA_LV
            const int hd = lane & 15, g4 = lane >> 4;
#pragma unroll
            for (int ks = 0; ks < 5; ++ks) qf[ks] = ldg16h(QCAT + (tokbase + wave) * 2560 + hd * 160 + 32 * ks + 8 * g4);
        }
        LAS unsigned short* sel = (LAS unsigned short*)(lds + DSA_SEL_OFF) + wave * 256;
        int nvalid;
        for (int repb = 0; repb < PROBE_REP_B; ++repb)
        {   DSA_LV
        if (t < 256) {
            for (int i = lane; i < 256; i += 64) sel[i] = (unsigned short)((i <= t) ? i : 0);
            nvalid = t + 1;
        } else {
            LAS unsigned* hist = (LAS unsigned*)(lds + DSA_HIST_OFF) + wave * 256;
            unsigned key[64];
            const int jmax = t >> 6;
#pragma unroll
            for (int jg = 0; jg < 16; ++jg) {
                if (4 * jg <= jmax) {
#pragma unroll
                    for (int jj = 0; jj < 4; ++jj) { const int j = 4 * jg + jj; const int idx = 64 * j + lane; const unsigned uu = __float_as_uint(scores[wave * 4096 + idx]);
                        const unsigned k = (uu >> 31) ? ~uu : (uu | 0x80000000u); key[j] = (idx <= t) ? k : 0u; }
                } else {
#pragma unroll
                    for (int jj = 0; jj < 4; ++jj) key[4 * jg + jj] = 0u;
                } }
            unsigned mxk = 0u;
#pragma unroll
            for (int jg = 0; jg < 16; ++jg) if (4 * jg <= jmax) {
#pragma unroll
                for (int jj = 0; jj < 4; ++jj) { const int j = 4 * jg + jj; mxk = key[j] > mxk ? key[j] : mxk; } }
            mxk = wave_max_u(mxk);
            unsigned base = mxk; int sh = 16, krem = 256;
#pragma unroll 1
            for (int it = 0; it < 12; ++it) {
                *(LAS u32x4*)(hist + 4 * lane) = (u32x4){0u, 0u, 0u, 0u};
                asm volatile("s_waitcnt lgkmcnt(0)" ::: "memory");
#pragma unroll
                for (int jg = 0; jg < 16; ++jg) if (4 * jg <= jmax) {
#pragma unroll
                    for (int jj = 0; jj < 4; ++jj) { const unsigned k = key[4 * jg + jj]; const unsigned bin = (base - k) >> sh;
                        if (bin < 256u && k != 0u) __hip_atomic_fetch_add(hist + bin, 1u, __ATOMIC_RELAXED, __HIP_MEMORY_SCOPE_WORKGROUP); } }
                asm volatile("s_waitcnt lgkmcnt(0)" ::: "memory");
                const u32x4 hv = *(const LAS u32x4*)(hist + 4 * lane);
                const int own = (int)(hv[0] + hv[1] + hv[2] + hv[3]);
                const int pre = wave_scan_incl_i(own);
                const int c0 = pre - own, c1 = c0 + (int)hv[0], c2 = c1 + (int)hv[1], c3 = c2 + (int)hv[2];
                int dsel = -1, csel = 0;
                if (c0 < krem && krem <= c0 + (int)hv[0]) { dsel = 0; csel = c0; }
                else if (c1 < krem && krem <= c1 + (int)hv[1]) { dsel = 1; csel = c1; }
                else if (c2 < krem && krem <= c2 + (int)hv[2]) { dsel = 2; csel = c2; }
                else if (c3 < krem && krem <= c3 + (int)hv[3]) { dsel = 3; csel = c3; }
                const unsigned long long mfound = __ballot(dsel >= 0);
                if (mfound == 0ull) { sh = sh + 6 > 24 ? 24 : sh + 6; continue; }
                const int src = __builtin_ctzll(mfound);
                const int bsel = __builtin_amdgcn_readlane(4 * lane + dsel, src), cbel = __builtin_amdgcn_readlane(csel, src);
                krem -= cbel; base -= ((unsigned)bsel << sh);
                if (sh == 0) break;
                sh = sh >= 8 ? sh - 8 : 0;
            }
            const unsigned prefix = base;
            const unsigned Tq = prefix;
            int cge = 0, ceq = 0;
#pragma unroll
            for (int jg = 0; jg < 16; ++jg) if (4 * jg <= jmax) {
#pragma unroll
                for (int jj = 0; jj < 4; ++jj) { const int j = 4 * jg + jj; cge += (key[j] >= Tq) ? 1 : 0; ceq += (key[j] == Tq) ? 1 : 0; } }
            const int toteq = wave_total_i(ceq);
            if (toteq == krem) {
                int pos = wave_scan_incl_i(cge) - cge;
#pragma unroll
                for (int jg = 0; jg < 16; ++jg) if (4 * jg <= jmax) {
#pragma unroll
                    for (int jj = 0; jj < 4; ++jj) { const int j = 4 * jg + jj; if (key[j] >= Tq) { if (pos < 256) sel[pos] = (unsigned short)(64 * j + lane); ++pos; } } }
            } else {
                const int need_eq = krem; int base = 0, eq_seen = 0;
#pragma unroll
                for (int j = 0; j < 64; ++j) if (j <= jmax) {
                    const bool gt = key[j] > Tq, eq = key[j] == Tq;
                    const unsigned long long m_eq = __ballot(eq);
                    const int rank_eq = eq_seen + mbcnt64(m_eq);
                    const bool take = gt || (eq && rank_eq < need_eq);
                    const unsigned long long m_tk = __ballot(take);
                    const int pos = base + mbcnt64(m_tk);
                    if (take && pos < 256) sel[pos] = (unsigned short)(64 * j + lane);
                    base += __builtin_popcountll(m_tk); eq_seen += __builtin_popcountll(m_eq);
                }
            }
            nvalid = 256;
        }
        }
        asm volatile("s_waitcnt lgkmcnt(0)" ::: "memory");
        for (int repc = 0; repc < PROBE_REP_C; ++repc)
        {   DSA_LV
            const int hd = lane & 15, g4 = lane >> 4;
            asm volatile("s_waitcnt vmcnt(0)" ::: "memory");
            const char* kbase = (const char*)(KCAT + (size_t)b * S * 160);
            LAS unsigned char* vb = lds + wave * 16384;
            const unsigned vb_addr = (unsigned)(uintptr_t)vb;
#define DSA_DMA(gsrc, ldsoff) do { unsigned keep_; asm volatile("s_mov_b32 %0, m0\n\ts_mov_b32 m0, %2\n\ts_nop 0\n\tglobal_load_lds_dwordx4 %1, off\n\ts_mov_b32 m0, %0" \
                : "=&s"(keep_) : "v"(gsrc), "s"((unsigned)__builtin_amdgcn_readfirstlane(vb_addr + (unsigned)(ldsoff))) : "memory"); } while (0)
#define DSA_KTILE(tl) do { const int kx_ = sel[16 * (tl) + hd]; const char* src_ = kbase + (size_t)kx_ * 320 + 16 * g4; \
                _Pragma("unroll") for (int ks_ = 0; ks_ < 5; ++ks_) DSA_DMA(src_ + 64 * ks_, ((tl) % 3) * 5120 + ks_ * 1024); } while (0)
            f32x4 o[8];
#pragma unroll
            for (int nb = 0; nb < 8; ++nb) o[nb] = (f32x4){0.f, 0.f, 0.f, 0.f};
            float mref = -1e30f, lsum = 0.f;
            const int li = lane & 15, tq = li >> 2, tp = li & 3;
            DSA_KTILE(0); DSA_KTILE(1); DSA_KTILE(2);
#pragma unroll
            for (int tl = 0; tl < 16; ++tl) {
                if (tl < 14) asm volatile("s_waitcnt vmcnt(10)" ::: "memory"); else if (tl == 14) asm volatile("s_waitcnt vmcnt(5)" ::: "memory"); else asm volatile("s_waitcnt vmcnt(0)" ::: "memory");
                const LAS unsigned char* sb = vb + (tl % 3) * 5120;
                bf16x8 kf[5];
#pragma unroll
                for (int ks = 0; ks < 5; ++ks) kf[ks] = *(const LAS bf16x8*)(sb + ks * 1024 + lane * 16);
                s16x4 vt[8];
#pragma unroll
                for (int nb = 0; nb < 8; ++nb) { const int d0 = 16 + 16 * nb;
                    vt[nb] = lds_tr16(sb + ((d0 >> 5) * 1024) + ((((d0 & 31) >> 3) + (tp >> 1)) * 256) + (4 * g4 + tq) * 16 + 8 * (tp & 1)); }
                asm volatile("s_waitcnt lgkmcnt(0)" ::: "memory");
                if (tl + 3 < 16) DSA_KTILE(tl + 3);
                f32x4 acc = {0.f, 0.f, 0.f, 0.f};
#pragma unroll
                for (int ks = 0; ks < 5; ++ks) acc = __builtin_amdgcn_mfma_f32_16x16x32_bf16(kf[ks], qf[ks], acc, 0, 0, 0);
#pragma unroll
                for (int rg = 0; rg < 4; ++rg) if (16 * tl + 4 * g4 + rg >= nvalid) acc[rg] = -INFINITY;
                const float lm = fmaxf(fmaxf(acc[0], acc[1]), fmaxf(acc[2], acc[3]));
                if (__any(lm > mref + 8.f)) {
                    float mx = fmaxf(lm, __shfl_xor(lm, 16)); mx = fmaxf(mx, __shfl_xor(mx, 32));
                    const float mn = fmaxf(mref, mx), alpha = fast_exp2((mref - mn) * LOG2E); mref = mn; lsum *= alpha;
#pragma unroll
                    for (int nb = 0; nb < 8; ++nb) o[nb] = o[nb] * alpha;
                }
                const float p0 = fast_exp2((acc[0] - mref) * LOG2E), p1 = fast_exp2((acc[1] - mref) * LOG2E), p2 = fast_exp2((acc[2] - mref) * LOG2E), p3 = fast_exp2((acc[3] - mref) * LOG2E);
                lsum += (p0 + p1) + (p2 + p3);
                u32x2 pw; pw.x = cvtpk(p0, p1); pw.y = cvtpk(p2, p3);
                const s16x4 pb = __builtin_bit_cast(s16x4, pw);
#pragma unroll
                for (int nb = 0; nb < 8; ++nb) o[nb] = __builtin_amdgcn_mfma_f32_16x16x16bf16_1k(vt[nb], pb, o[nb], 0, 0, 0);
            }
            lsum += __shfl_xor(lsum, 16); lsum += __shfl_xor(lsum, 32);
#undef DSA_DMA
#undef DSA_KTILE
#undef DSA_VCHUNK
            const float inv = 1.f / lsum;
            bf16_t* op = OLAT + (tokbase + wave) * 2048 + hd * 128 + 4 * g4;
#pragma unroll
            for (int nb = 0; nb < 8; ++nb) { u32x2 w; w.x = cvtpk(o[nb][0] * inv, o[nb][1] * inv); w.y = cvtpk(o[nb][2] * inv, o[nb][3] * inv); stg8(op + 16 * nb, w); }
        }
        __syncthreads();
    }
#undef DSA_LV
}

constexpr int NSA_TB = 16384, NSA_PCS = 65536, NSA_SELM = 132096, NSA_UM = 132608, NSA_WSF = 132672, NSA_OST = 0;
constexpr int PCS_LD = 65;
static_assert(NSA_PCS + PCS_LD * 256 * 4 <= NSA_SELM && NSA_WSF + 2048 <= DSA_SEL_OFF + 16384 && NSA_WSF + 2048 <= LDS_MISC, "NSA LDS map");
__device__ __forceinline__ int crow(int r, int hi) { return (r & 3) + 8 * (r >> 2) + 4 * hi; }

struct BrState { float m, l; f32x16 o0, o1; };

__device__ __forceinline__ void nsa_qkt(f32x16& p0, f32x16& p1, const LAS unsigned char* tb, const bf16x8 (&qr)[4], int r32, int hi) {
    const LAS unsigned char* kb = tb + hi * 1024 + r32 * 16;
    p0 = (f32x16){}; p1 = (f32x16){};
#pragma unroll
    for (int d0 = 0; d0 < 4; ++d0) {
        const bf16x8 b0 = *(const LAS bf16x8*)(kb + d0 * 2048), b1 = *(const LAS bf16x8*)(kb + d0 * 2048 + 512);
        p0 = __builtin_amdgcn_mfma_f32_32x32x16_bf16(b0, qr[d0], p0, 0, 0, 0);
        p1 = __builtin_amdgcn_mfma_f32_32x32x16_bf16(b1, qr[d0], p1, 0, 0, 0);
    }
}
__device__ __forceinline__ float half_swap_max(float v) { auto rr = __builtin_amdgcn_permlane32_swap(__float_as_uint(v), __float_as_uint(v), false, false); return fmaxf(__uint_as_float(rr[0]), __uint_as_float(rr[1])); }
__device__ __forceinline__ float half_swap_sum(float v) { auto rr = __builtin_amdgcn_permlane32_swap(__float_as_uint(v), __float_as_uint(v), false, false); return __uint_as_float(rr[0]) + __uint_as_float(rr[1]); }

__device__ __forceinline__ void nsa_update(BrState& st, f32x16& p0, f32x16& p1, const LAS unsigned char* tb, LAS float* wsf, int r32, int hi, int lane, bool active) {
    float rm = fmaxf(fmaxf(p0[0], p0[1]), fmaxf(p1[0], p1[1]));
#pragma unroll
    for (int r = 2; r < 16; r += 2) rm = fmaxf(rm, fmaxf(fmaxf(p0[r], p0[r + 1]), fmaxf(p1[r], p1[r + 1])));
    rm = half_swap_max(rm);
    if (!active) rm = -INFINITY;
    if (__any(rm > st.m + 8.f)) {
        const float mn = fmaxf(st.m, rm), alpha = fast_exp2(st.m - mn); st.m = mn; st.l *= alpha;
        if (hi == 0) wsf[r32] = alpha;
        asm volatile("s_waitcnt lgkmcnt(0)" ::: "memory");
#pragma unroll
        for (int r = 0; r < 16; ++r) { const float f = wsf[crow(r, hi)]; st.o0[r] *= f; st.o1[r] *= f; }
    }
    const float mref = active ? st.m : INFINITY;
    float sum = 0.f;
#pragma unroll
    for (int r = 0; r < 16; ++r) { p0[r] = fast_exp2(p0[r] - mref); p1[r] = fast_exp2(p1[r] - mref); sum += p0[r] + p1[r]; }
    st.l += sum;
    u32x4 pw0, pw1, pw2, pw3;
    pw0 = (u32x4){cvtpk(p0[0], p0[1]), cvtpk(p0[2], p0[3]), cvtpk(p0[4], p0[5]), cvtpk(p0[6], p0[7])};
    pw1 = (u32x4){cvtpk(p0[8], p0[9]), cvtpk(p0[10], p0[11]), cvtpk(p0[12], p0[13]), cvtpk(p0[14], p0[15])};
    pw2 = (u32x4){cvtpk(p1[0], p1[1]), cvtpk(p1[2], p1[3]), cvtpk(p1[4], p1[5]), cvtpk(p1[6], p1[7])};
    pw3 = (u32x4){cvtpk(p1[8], p1[9]), cvtpk(p1[10], p1[11]), cvtpk(p1[12], p1[13]), cvtpk(p1[14], p1[15])};
    const LAS unsigned char* vp0 = tb + 8192 + ((lane >> 4) & 1) * 32 + (lane & 3) * 8 + (4 * hi + ((lane & 15) >> 2)) * 64;
#pragma unroll
    for (int d0 = 0; d0 < 2; ++d0) {
        f32x16 o = d0 ? st.o1 : st.o0;
#pragma unroll
        for (int kg = 0; kg < 4; ++kg) {
            const s16x4 lo = lds_tr16(vp0 + d0 * 4096 + kg * 1024), hh = lds_tr16(vp0 + d0 * 4096 + kg * 1024 + 512);
            const bf16x8 vf = (bf16x8){lo[0], lo[1], lo[2], lo[3], hh[0], hh[1], hh[2], hh[3]};
            const u32x4 pw = kg == 0 ? pw0 : kg == 1 ? pw1 : kg == 2 ? pw2 : pw3;
            o = __builtin_amdgcn_mfma_f32_32x32x16_bf16(__builtin_bit_cast(bf16x8, pw), vf, o, 0, 0, 0);
        }
        if (d0) st.o1 = o; else st.o0 = o;
    }
}
__device__ __forceinline__ void nsa_finish(const BrState& st, f32x16& a0, f32x16& a1, float gate, LAS float* wsf, int r32, int hi) {
    const float lt = half_swap_sum(st.l);
    const float sc = lt > 0.f ? gate / lt : 0.f;
    if (hi == 0) wsf[32 + r32] = sc;
    asm volatile("s_waitcnt lgkmcnt(0)" ::: "memory");
#pragma unroll
    for (int r = 0; r < 16; ++r) { const float f = wsf[32 + crow(r, hi)]; a0[r] += st.o0[r] * f; a1[r] += st.o1[r] * f; }
}
template <bool DOV, class RowF, class NextF, class BodyF>
__device__ __forceinline__ void nsa_stream(LAS unsigned char* lds, const bf16_t* base, int kcol, int vcol, int first, const RowF& rowf, const NextF& nextf, const BodyF& body, int wave, int lane) {
    const unsigned lds0 = (unsigned)(uintptr_t)lds;
    auto dma = [&](const char* gsrc, unsigned ldsoff) { unsigned keep_;
        asm volatile("s_mov_b32 %0, m0\n\ts_mov_b32 m0, %2\n\ts_nop 0\n\tglobal_load_lds_dwordx4 %1, off\n\ts_mov_b32 m0, %0" : "=&s"(keep_) : "v"(gsrc), "s"((unsigned)__builtin_amdgcn_readfirstlane(lds0 + ldsoff)) : "memory"); };
    auto issue = [&](int t, int slot) {
        dma((const char*)(base + rowf(t, lane) + kcol) + wave * 16, (unsigned)(slot * NSA_TB + wave * 1024));
        if (DOV) dma((const char*)(base + rowf(t, 16 * (wave & 3) + (lane >> 2)) + vcol) + (wave >> 2) * 64 + (lane & 3) * 16, (unsigned)(slot * NSA_TB + 8192 + wave * 1024)); };
    int c0 = first, c1 = c0 >= 0 ? nextf(c0) : -1, pr = 0;
    asm volatile("s_waitcnt vmcnt(0) lgkmcnt(0)" ::: "memory");
    __syncthreads();
    if (c0 >= 0) issue(c0, 0);
    if (c1 >= 0) issue(c1, 1);
    while (c0 >= 0) {
        const int n0 = c1 >= 0 ? nextf(c1) : -1, n1 = n0 >= 0 ? nextf(n0) : -1;
        asm volatile("s_waitcnt vmcnt(0) lgkmcnt(0)\n\ts_barrier" ::: "memory");
        if (n0 >= 0) issue(n0, (pr ^ 1) * 2);
        if (n1 >= 0) issue(n1, (pr ^ 1) * 2 + 1);
        body(c0, (const LAS unsigned char*)(lds + (pr * 2) * NSA_TB));
        if (c1 >= 0) body(c1, (const LAS unsigned char*)(lds + (pr * 2 + 1) * NSA_TB));
        c0 = n0; c1 = n1; pr ^= 1;
    }
}

__device__ __forceinline__ void nsa_core(const bf16_t* P1, const bf16_t* KV, const float* GATES, bf16_t* ONSA, LAS unsigned char* lds, int bid, int G, int wave, int lane0) {
    const int hh = wave & 3, qs = wave >> 2;
    LAS float* pcs = (LAS float*)(lds + NSA_PCS); LAS unsigned* pcsu = (LAS unsigned*)(lds + NSA_PCS);
    LAS unsigned long long* selm = (LAS unsigned long long*)(lds + NSA_SELM);
    LAS unsigned long long* um = (LAS unsigned long long*)(lds + NSA_UM);
    LAS float* wsf = (LAS float*)(lds + NSA_WSF) + wave * 64;
#define NSA_LV int lane_ = lane0; asm volatile("" : "+v"(lane_)); const int lane = lane_, tid = wave * 64 + lane, r32 = lane & 31, hi = lane >> 5; const int tq = t0 + 32 * qs + r32; (void)tid; (void)hi; (void)tq;
    for (int u = bid; u < 2048; u += G) {
        const int b = u & 7, g = (u >> 3) & 3, ss = (u >> 5) & 7, ii = u >> 8;
        const int qt = (ii & 1) ? (ii * 8 + 7 - ss) : (ii * 8 + ss);
        const int t0 = qt * 64, head = 4 * g + hh;
        bf16x8 qr[4]; float g_cmp, g_sel, g_win;
        f32x16 a0 = {}, a1 = {};
        BrState sc; sc.m = -1e30f; sc.l = 0.f; sc.o0 = (f32x16){}; sc.o1 = (f32x16){};
        const int nvmax = ((t0 + 63 - 31) >> 4) + 1;
        const int nct = (nvmax + 63) >> 6;
        auto cmp_row = [&](int tl, int key) -> long { int n = 64 * tl + key; n = n < 255 ? n : 254; return (long)(((size_t)b * 256 + n) * 4 + g) * 128; };
        auto cmp_next = [&](int tl) -> int { return tl + 1 < nct ? tl + 1 : -1; };
        {   NSA_LV
            const size_t tok = (size_t)b * S + tq;
#pragma unroll
            for (int d0 = 0; d0 < 4; ++d0) qr[d0] = ldg16h(P1 + tok * FF + head * 64 + 16 * d0 + 8 * hi);
            g_cmp = GATES[tok * 48 + head * 3 + 0]; g_sel = GATES[tok * 48 + head * 3 + 1]; g_win = GATES[tok * 48 + head * 3 + 2];
            for (int i = tid; i < PCS_LD * 256; i += 512) pcs[i] = 0.f;
            const int nv = (tq >= 31) ? ((tq - 31) >> 4) + 1 : 0;
            nsa_stream<true>(lds, KV, 0, 64, 0, cmp_row, cmp_next, [&](int tl, const LAS unsigned char* tb) {
                f32x16 p0, p1; nsa_qkt(p0, p1, tb, qr, r32, hi);
#pragma unroll
                for (int r = 0; r < 16; ++r) { const int n = 64 * tl + crow(r, hi); if (n >= nv) p0[r] = -INFINITY; if (n + 32 >= nv) p1[r] = -INFINITY; }
                nsa_update(sc, p0, p1, tb, wsf, r32, hi, lane, true); }, wave, lane);
            nsa_finish(sc, a0, a1, g_cmp, wsf, r32, hi);
        }
        {   NSA_LV
            const int nv = (tq >= 31) ? ((tq - 31) >> 4) + 1 : 0;
            const float lt = half_swap_sum(sc.l); const float il2 = lt > 0.f ? 67108864.f / lt : 0.f;
            for (int tl = 0; tl < nct; ++tl) { const LAS unsigned char* tb = lds + tl * NSA_TB;
                f32x16 p0, p1; nsa_qkt(p0, p1, tb, qr, r32, hi);
#pragma unroll
                for (int r = 0; r < 16; ++r) { const int n = 64 * tl + crow(r, hi);
                    if (n < nv) __hip_atomic_fetch_add(pcsu + n * PCS_LD + qs * 32 + r32, (unsigned)(fast_exp2(p0[r] - sc.m) * il2 + 0.5f), __ATOMIC_RELAXED, __HIP_MEMORY_SCOPE_WORKGROUP);
                    if (n + 32 < nv) __hip_atomic_fetch_add(pcsu + (n + 32) * PCS_LD + qs * 32 + r32, (unsigned)(fast_exp2(p1[r] - sc.m) * il2 + 0.5f), __ATOMIC_RELAXED, __HIP_MEMORY_SCOPE_WORKGROUP); } }
        }
        __syncthreads();
        {   NSA_LV
            const int qi = lane >> 3, oc = lane & 7, q = 8 * wave + qi, cur = qt;
            unsigned key[8];
#pragma unroll
            for (int r = 0; r < 8; ++r) { const int j = 8 * oc + r; unsigned imp = 0u;
#pragma unroll
                for (int k = 0; k < 5; ++k) { const int n = 4 * j - 1 + k; if (n >= 0 && n < 255) imp += pcsu[n * PCS_LD + q]; }
                unsigned kk = imp + 1u;
                if (j == 0 || j == cur || j == cur - 1) kk = 0x7f000000u;
                key[r] = (j <= cur) ? kk : 0u; }
            auto gsum = [&](int v) -> int {
                v += __builtin_amdgcn_update_dpp(0, v, 0xB1, 0xF, 0xF, true); v += __builtin_amdgcn_update_dpp(0, v, 0x4E, 0xF, 0xF, true); v += __builtin_amdgcn_update_dpp(0, v, 0x141, 0xF, 0xF, true); return v; };
            unsigned selb = 0u;
            if (cur < 16) {
#pragma unroll
                for (int r = 0; r < 8; ++r) selb |= (key[r] != 0u) ? (1u << r) : 0u;
            } else {
                unsigned Tk = 0u;
#pragma unroll 1
                for (int bit = 30; bit >= 0; --bit) { const unsigned cand = Tk | (1u << bit); int c = 0;
#pragma unroll
                    for (int r = 0; r < 8; ++r) c += (key[r] >= cand) ? 1 : 0;
                    c = gsum(c); if (c >= 16) Tk = cand; }
                int cgt = 0, ceq = 0;
#pragma unroll
                for (int r = 0; r < 8; ++r) { cgt += (key[r] > Tk) ? 1 : 0; ceq += (key[r] == Tk) ? 1 : 0; }
                const int need_eq = 16 - gsum(cgt);
                int pre = ceq;
                { int v = __shfl_up(pre, 1, 8); if (oc >= 1) pre += v; v = __shfl_up(pre, 2, 8); if (oc >= 2) pre += v; v = __shfl_up(pre, 4, 8); if (oc >= 4) pre += v; }
                int eqi = pre - ceq;
#pragma unroll
                for (int r = 0; r < 8; ++r) { const bool gt = key[r] > Tk, eq = key[r] == Tk; const bool take = gt || (eq && eqi < need_eq); eqi += eq ? 1 : 0; selb |= take ? (1u << r) : 0u; }
            }
            unsigned mlo = oc < 4 ? (selb << (8 * oc)) : 0u, mhi = oc >= 4 ? (selb << (8 * (oc - 4))) : 0u;
            mlo |= (unsigned)__builtin_amdgcn_update_dpp(0, (int)mlo, 0xB1, 0xF, 0xF, true); mhi |= (unsigned)__builtin_amdgcn_update_dpp(0, (int)mhi, 0xB1, 0xF, 0xF, true);
            mlo |= (unsigned)__builtin_amdgcn_update_dpp(0, (int)mlo, 0x4E, 0xF, 0xF, true); mhi |= (unsigned)__builtin_amdgcn_update_dpp(0, (int)mhi, 0x4E, 0xF, 0xF, true);
            mlo |= (unsigned)__builtin_amdgcn_update_dpp(0, (int)mlo, 0x141, 0xF, 0xF, true); mhi |= (unsigned)__builtin_amdgcn_update_dpp(0, (int)mhi, 0x141, 0xF, 0xF, true);
            if (oc == 0) selm[q] = ((unsigned long long)mhi << 32) | mlo;
            unsigned ulo = mlo, uhi = mhi;
#pragma unroll
            for (int o = 8; o < 64; o <<= 1) { ulo |= (unsigned)__shfl_xor((int)ulo, o); uhi |= (unsigned)__shfl_xor((int)uhi, o); }
            const unsigned long long uni = ((unsigned long long)uhi << 32) | ulo;
            if (lane == 0) um[wave] = uni;
        }
        __syncthreads();
        {   NSA_LV
            unsigned long long umask = 0ull;
#pragma unroll
            for (int w = 0; w < 8; ++w) umask |= um[w];
            const unsigned long long mymask = selm[32 * qs + r32];
            BrState sb; sb.m = -1e30f; sb.l = 0.f; sb.o0 = (f32x16){}; sb.o1 = (f32x16){};
            auto nextsel = [&](int j) -> int { const unsigned long long rest = (j >= 63) ? 0ull : (umask >> (j + 1)); if (rest == 0ull) return -1; const int nj = j + 1 + __builtin_ctzll(rest); return nj <= qt ? nj : -1; };
            nsa_stream<true>(lds, P1, 1536 + g * 64, 1792 + g * 64, nextsel(-1),
                [&](int j, int key) -> long { return (long)((size_t)b * S + 64 * j + key) * FF; }, nextsel,
                [&](int j, const LAS unsigned char* tb) {
                    const bool bsel = (mymask >> j) & 1ull;
                    if (!__any(bsel)) return;
                    f32x16 p0, p1; nsa_qkt(p0, p1, tb, qr, r32, hi);
                    if (j == qt) {
#pragma unroll
                        for (int r = 0; r < 16; ++r) { const int pos = 64 * j + crow(r, hi); if (pos > tq) p0[r] = -INFINITY; if (pos + 32 > tq) p1[r] = -INFINITY; } }
                    nsa_update(sb, p0, p1, tb, wsf, r32, hi, lane, bsel); }, wave, lane);
            nsa_finish(sb, a0, a1, g_sel, wsf, r32, hi);
        }
        {   NSA_LV
            BrState sw; sw.m = -1e30f; sw.l = 0.f; sw.o0 = (f32x16){}; sw.o1 = (f32x16){};
            const int j0 = (t0 - 511) > 0 ? (t0 - 511) >> 6 : 0;
            nsa_stream<true>(lds, P1, 2048 + g * 64, 2304 + g * 64, j0,
                [&](int j, int key) -> long { return (long)((size_t)b * S + 64 * j + key) * FF; },
                [&](int j) -> int { return j < qt ? j + 1 : -1; },
                [&](int j, const LAS unsigned char* tb) {
                    f32x16 p0, p1; nsa_qkt(p0, p1, tb, qr, r32, hi);
                    const int tqmin = t0 + 32 * qs;
                    if (!(64 * j + 63 <= tqmin && 64 * j > tqmin + 31 - 512)) {
#pragma unroll
                        for (int r = 0; r < 16; ++r) { const int pos = 64 * j + crow(r, hi);
                            if (pos > tq || pos <= tq - 512) p0[r] = -INFINITY; if (pos + 32 > tq || pos + 32 <= tq - 512) p1[r] = -INFINITY; } }
                    nsa_update(sw, p0, p1, tb, wsf, r32, hi, lane, true); }, wave, lane);
            nsa_finish(sw, a0, a1, g_win, wsf, r32, hi);
        }
        __syncthreads();
        {   NSA_LV
            LAS bf16_t* stg = (LAS bf16_t*)(lds + NSA_OST) + wave * 2048;
#pragma unroll
            for (int r = 0; r < 16; ++r) { const int orow = crow(r, hi);
                stg[orow * 64 + r32] = (bf16_t)(cvtpk(a0[r], 0.f) & 0xffffu); stg[orow * 64 + 32 + r32] = (bf16_t)(cvtpk(a1[r], 0.f) & 0xffffu); }
            asm volatile("s_waitcnt lgkmcnt(0)" ::: "memory");
            bf16_t* ob = ONSA + ((size_t)b * S + t0 + 32 * qs) * D + head * 64;
#pragma unroll
            for (int i = 0; i < 4; ++i) { const int row = i * 8 + (lane >> 3), ch = lane & 7; const u32x4 v = *(const LAS u32x4*)(stg + row * 64 + ch * 8); stg16(ob + (size_t)row * D + ch * 8, v); }
        }
        __syncthreads();
    }
#undef NSA_LV
}

__device__ __forceinline__ bool moe_chunk(const unsigned* cnt, int c, int& e_out, int& tile0, int& ntl) {
    int ci = 0, toff = 0;
    for (int e = 0; e < NE; ++e) { const int nte = ((int)cnt[e] + 255) >> 8;
        for (int s = 0; s < nte; s += CAPT) { if (ci == c) { e_out = e; tile0 = toff + s; ntl = (nte - s) < CAPT ? (nte - s) : CAPT; return true; } ++ci; }
        toff += nte; }
    return false;
}
__device__ __forceinline__ int moe_nchunks(const unsigned* cnt) { int ci = 0; for (int e = 0; e < NE; ++e) { const int nte = ((int)cnt[e] + 255) >> 8; ci += (nte + CAPT - 1) / CAPT; } return ci; }

__device__ __forceinline__ void moe_route(const float* X, const float* g, const float* mod, const float* wr, unsigned* gcnt, int* ROUTEE, float* ROUTEG,
                                          LAS unsigned char* lds, int bid, int G, int wave, int lane) {
    const int tidx = wave * 64 + lane;
    LAS unsigned* lcnt = (LAS unsigned*)lds;
    LAS int* le = (LAS int*)(lds + 64);
    LAS float* lg = (LAS float*)(lds + 64 + 1024);
    for (int blk = bid; blk < T / 128; blk += G) {
        __syncthreads();
        if (tidx < 16) lcnt[tidx] = 0u;
        __syncthreads();
        f32x4 vn[4];
#pragma unroll
        for (int j = 0; j < 4; ++j) vn[j] = ldg16f(X + (size_t)(blk * 128 + wave * 16) * D + 4 * lane + 256 * j);
        for (int i = 0; i < 16; ++i) {
            const int tl = wave * 16 + i, m = blk * 128 + tl; const float* modb = mod + (size_t)(m >> 12) * 3072;
            f32x4 v[4]; float ss = 0.f;
#pragma unroll
            for (int j = 0; j < 4; ++j) v[j] = vn[j];
            { const int mn = blk * 128 + wave * 16 + (i + 1 < 16 ? i + 1 : i);
#pragma unroll
              for (int j = 0; j < 4; ++j) vn[j] = ldg16f(X + (size_t)mn * D + 4 * lane + 256 * j); }
#pragma unroll
            for (int j = 0; j < 4; ++j) ss += (v[j][0] * v[j][0] + v[j][1] * v[j][1]) + (v[j][2] * v[j][2] + v[j][3] * v[j][3]);
            const float r = 1.f / sqrtf(wave_sum(ss) * (1.f / D) + EPS);
            float lg8[8];
#pragma unroll
            for (int e = 0; e < 8; ++e) lg8[e] = 0.f;
#pragma unroll
            for (int j = 0; j < 4; ++j) { const int c = 4 * lane + 256 * j;
                const f32x4 gv = *(const f32x4*)(g + c), sh = *(const f32x4*)(modb + c), sc = *(const f32x4*)(modb + D + c);
                const f32x4 y = (v[j] * r) * gv * (sc + 1.f) + sh;
#pragma unroll
                for (int q = 0; q < 4; ++q) { const f32x4 w0 = *(const f32x4*)(wr + (size_t)(c + q) * 8), w1 = *(const f32x4*)(wr + (size_t)(c + q) * 8 + 4);
                    lg8[0] += y[q] * w0[0]; lg8[1] += y[q] * w0[1]; lg8[2] += y[q] * w0[2]; lg8[3] += y[q] * w0[3];
                    lg8[4] += y[q] * w1[0]; lg8[5] += y[q] * w1[1]; lg8[6] += y[q] * w1[2]; lg8[7] += y[q] * w1[3]; } }
#pragma unroll
            for (int e = 0; e < 8; ++e) lg8[e] = wave_sum(lg8[e]);
            int e0 = 0; float l0 = lg8[0];
#pragma unroll
            for (int e = 1; e < 8; ++e) if (lg8[e] > l0) { l0 = lg8[e]; e0 = e; }
            int e1 = -1; float l1 = -INFINITY;
#pragma unroll
            for (int e = 0; e < 8; ++e) if (e != e0 && lg8[e] > l1) { l1 = lg8[e]; e1 = e; }
            const float g0 = 1.f / (1.f + __expf(l1 - l0)), g1 = 1.f - g0;
            if (lane == 0) {
                const unsigned p0 = __hip_atomic_fetch_add(lcnt + e0, 1u, __ATOMIC_RELAXED, __HIP_MEMORY_SCOPE_WORKGROUP);
                const unsigned p1 = __hip_atomic_fetch_add(lcnt + e1, 1u, __ATOMIC_RELAXED, __HIP_MEMORY_SCOPE_WORKGROUP);
                le[tl * 2] = e0 | (int)(p0 << 4); le[tl * 2 + 1] = e1 | (int)(p1 << 4); lg[tl * 2] = g0; lg[tl * 2 + 1] = g1; }
        }
        __syncthreads();
        if (tidx < 8) lcnt[8 + tidx] = __hip_atomic_fetch_add(gcnt + tidx, lcnt[tidx], __ATOMIC_RELAXED, __HIP_MEMORY_SCOPE_AGENT);
        __syncthreads();
        if (tidx < 256) { const int ent = tidx; const int v = le[ent]; const int e = v & 15; const int pos = (v >> 4) + (int)lcnt[8 + e];
            ROUTEE[(size_t)blk * 256 + ent] = e | (pos << 4); ROUTEG[(size_t)blk * 256 + ent] = lg[ent]; }
    }
}
__device__ __forceinline__ void moe_fill(const float* X, const float* g, const float* mod, const unsigned* cnt, const int* ROUTEE, const float* ROUTEG,
                                         bf16_t* AMOE, int* SLOTTOK, float* SLOTGATE, int gw, int NGW, int lane) {
    auto offs = [&](int ee) -> int { int a = 0; for (int e = 0; e < NE; ++e) { if (e < ee) a += (((int)cnt[e] + 255) >> 8) << 8; } return a; };
    f32x4 vn[4]; int ran, rbn;
    { const int m0 = gw < T ? gw : T - 1;
#pragma unroll
      for (int j = 0; j < 4; ++j) vn[j] = ldg16f(X + (size_t)m0 * D + 4 * lane + 256 * j);
      ran = ROUTEE[(size_t)m0 * 2]; rbn = ROUTEE[(size_t)m0 * 2 + 1]; }
    for (int m = gw; m < T; m += NGW) {
        const float* modb = mod + (size_t)(m >> 12) * 3072;
        f32x4 v[4]; float ss = 0.f;
#pragma unroll
        for (int j = 0; j < 4; ++j) v[j] = vn[j];
        const int ra = ran, rb = rbn;
        { const int mn = (m + NGW < T) ? m + NGW : m;
#pragma unroll
          for (int j = 0; j < 4; ++j) vn[j] = ldg16f(X + (size_t)mn * D + 4 * lane + 256 * j);
          ran = ROUTEE[(size_t)mn * 2]; rbn = ROUTEE[(size_t)mn * 2 + 1]; }
#pragma unroll
        for (int j = 0; j < 4; ++j) ss += (v[j][0] * v[j][0] + v[j][1] * v[j][1]) + (v[j][2] * v[j][2] + v[j][3] * v[j][3]);
        const float r = 1.f / sqrtf(wave_sum(ss) * (1.f / D) + EPS);
        const int oa = offs(ra & 15), ob = offs(rb & 15);
        const size_t sa = (size_t)(oa + (ra >> 4)), sb = (size_t)(ob + (rb >> 4));
#pragma unroll
        for (int j = 0; j < 4; ++j) { const int c = 4 * lane + 256 * j;
            const f32x4 gv = *(const f32x4*)(g + c), sh = *(const f32x4*)(modb + c), sc = *(const f32x4*)(modb + D + c);
            const f32x4 y = (v[j] * r) * gv * (sc + 1.f) + sh;
            u32x2 o; o.x = cvtpk(y[0], y[1]); o.y = cvtpk(y[2], y[3]);
            *(u32x2*)(AMOE + sa * D + c) = o; *(u32x2*)(AMOE + sb * D + c) = o; }
        if (lane == 0) { SLOTTOK[sa] = m; SLOTTOK[sb] = m; SLOTGATE[sa] = ROUTEG[(size_t)m * 2]; SLOTGATE[sb] = ROUTEG[(size_t)m * 2 + 1]; }
    }
    for (int pr = gw; pr < NE * 256; pr += NGW) { const int e = pr >> 8, i = pr & 255; const int oe = offs(e), ce = (int)cnt[e];
        const int padn = ((ce + 255) & ~255) - ce;
        if (i < padn) { const size_t sr = (size_t)(oe + ce + i);
#pragma unroll
            for (int j = 0; j < 4; ++j) *(u32x2*)(AMOE + sr * D + 4 * lane + 256 * j) = (u32x2){0u, 0u};
            if (lane == 0) { SLOTTOK[sr] = -1; SLOTGATE[sr] = 0.f; } } }
}
__device__ __forceinline__ void final_rows_subset(const float* X, const float* g, float* out, const int* ROUTEE, int e_last, bool want_last, int gw, int NGW, int lane) {
    for (int m = gw; m < T; m += NGW) {
        const int ra = ROUTEE[(size_t)m * 2] & 15, rb = ROUTEE[(size_t)m * 2 + 1] & 15;
        const bool has = (ra == e_last) || (rb == e_last);
        if (has != want_last) continue;
        f32x4 va[4]; float sa = 0.f;
#pragma unroll
        for (int j = 0; j < 4; ++j) va[j] = ldg16f(X + (size_t)m * D + 4 * lane + 256 * j);
#pragma unroll
        for (int j = 0; j < 4; ++j) sa += (va[j][0] * va[j][0] + va[j][1] * va[j][1]) + (va[j][2] * va[j][2] + va[j][3] * va[j][3]);
        const float ra_ = 1.f / sqrtf(wave_sum(sa) * (1.f / D) + EPS);
#pragma unroll
        for (int j = 0; j < 4; ++j) { const int c = 4 * lane + 256 * j; *(GAS f32x4*)(out + (size_t)m * D + c) = (va[j] * ra_) * *(const f32x4*)(g + c); }
    }
}
__device__ __forceinline__ void final_rows(const float* X, const float* g, float* out, int gw, int NGW, int lane) {
    for (int m = gw; m < T; m += 2 * NGW) { const int m2 = m + NGW;
        f32x4 va[4], vb[4]; float sa = 0.f, sb = 0.f;
#pragma unroll
        for (int j = 0; j < 4; ++j) va[j] = ldg16f(X + (size_t)m * D + 4 * lane + 256 * j);
        if (m2 < T) {
#pragma unroll
            for (int j = 0; j < 4; ++j) vb[j] = ldg16f(X + (size_t)m2 * D + 4 * lane + 256 * j); }
#pragma unroll
        for (int j = 0; j < 4; ++j) sa += (va[j][0] * va[j][0] + va[j][1] * va[j][1]) + (va[j][2] * va[j][2] + va[j][3] * va[j][3]);
        const float ra = 1.f / sqrtf(wave_sum(sa) * (1.f / D) + EPS);
#pragma unroll
        for (int j = 0; j < 4; ++j) { const int c = 4 * lane + 256 * j; *(GAS f32x4*)(out + (size_t)m * D + c) = (va[j] * ra) * *(const f32x4*)(g + c); }
        if (m2 < T) {
#pragma unroll
            for (int j = 0; j < 4; ++j) sb += (vb[j][0] * vb[j][0] + vb[j][1] * vb[j][1]) + (vb[j][2] * vb[j][2] + vb[j][3] * vb[j][3]);
            const float rb = 1.f / sqrtf(wave_sum(sb) * (1.f / D) + EPS);
#pragma unroll
            for (int j = 0; j < 4; ++j) { const int c = 4 * lane + 256 * j; *(GAS f32x4*)(out + (size_t)m2 * D + c) = (vb[j] * rb) * *(const f32x4*)(g + c); } }
    }
}

enum { PH_PRO = 0, PH_MOD0, PH_IN0, PH_DPOST, PH_Q, PH_DSA, PH_WO0, PH_MOD1, PH_UP, PH_DOWN, PH_MOD2, PH_NIN, PH_CMP1, PH_CMP2, PH_NSA, PH_WO1, PH_ROUTE, PH_FILL, PH_MOE0,
       PH_MOE_N = 14, PH_FINAL = PH_MOE0 + PH_MOE_N, PH_COUNT };

#define KPARAMS const float* __restrict__ in0, const float* __restrict__ in1, const float* __restrict__ in2, const float* __restrict__ in3, const float* __restrict__ in4, const float* __restrict__ in5, const float* __restrict__ in6, const float* __restrict__ in7, const float* __restrict__ in8, const float* __restrict__ in9, const float* __restrict__ in10, const float* __restrict__ in11, const float* __restrict__ in12, const float* __restrict__ in13, const float* __restrict__ in14, const float* __restrict__ in15, const float* __restrict__ in16, const float* __restrict__ in17, const float* __restrict__ in18, const float* __restrict__ in19, const float* __restrict__ in20, const float* __restrict__ in21, const float* __restrict__ in22, const float* __restrict__ in23, const float* __restrict__ in24, const float* __restrict__ in25, const float* __restrict__ in26, const float* __restrict__ in27, const float* __restrict__ in28, float* out_p, unsigned char* ws_p, int ph_lo, int ph_hi
__global__ void __launch_bounds__(512, 2) fwd_kernel(KPARAMS) {
    const float* const in[29] = {in0, in1, in2, in3, in4, in5, in6, in7, in8, in9, in10, in11, in12, in13, in14, in15, in16, in17, in18, in19, in20, in21, in22, in23, in24, in25, in26, in27, in28};
    extern __shared__ __attribute__((aligned(16))) unsigned char lds_raw[];
    LAS unsigned char* lds = (LAS unsigned char*)lds_raw;
#if MK_SPLIT
#define IN(k) (PH_EN(k) && ph_lo <= (k) && (k) < ph_hi)
#define GRID_BAR() do { } while (0)
#else
#define IN(k) PH_EN(k)
    if (threadIdx.x < 4) ((LAS unsigned*)(lds + LDS_MISC))[threadIdx.x] = 0u;
    __syncthreads();
    (void)xcd_barrier_post((unsigned*)(ws_p + WS_CTL) + CW_BAR, (volatile LAS unsigned*)(lds + LDS_MISC));
#define GRID_BAR() do { XcdBarrier _b; _b.bar = (unsigned*)(ws_p + WS_CTL) + CW_BAR; _b.x = xb_xcc_id(); _b.st = (volatile LAS unsigned*)(lds + LDS_MISC); int _ln; asm volatile("v_mbcnt_lo_u32_b32 %0, -1, 0\n\tv_mbcnt_hi_u32_b32 %0, -1, %0" : "=v"(_ln)); xcd_barrier(_b, (wave0 == 0) && (_ln == 0)); } while (0)
#endif
    const int wave0 = __builtin_amdgcn_readfirstlane(threadIdx.x >> 6);
#define PHV size_t wsz_ = 0; asm volatile("" : "+s"(wsz_)); unsigned char* ws = ws_p + wsz_; int lane; asm volatile("v_mbcnt_lo_u32_b32 %0, -1, 0\n\tv_mbcnt_hi_u32_b32 %0, -1, %0" : "=v"(lane)); \
    int wave = wave0; asm volatile("" : "+s"(wave)); const int tid = wave * 64 + lane; const int G = gridDim.x, bid = blockIdx.x; const int gw = bid * 8 + wave, NGW = G * 8; (void)tid; \
    LAS float* scr = (LAS float*)(lds + wave * 8448); (void)lane; (void)gw; (void)NGW; (void)scr; (void)ws;
#define MOD ((float*)(ws + WS_MOD))
#define ROPEC ((float*)(ws + WS_ROPEC))
#define ROPES ((float*)(ws + WS_ROPES))
#define BIASKV ((float*)(ws + WS_BIASKV))
#define X ((float*)(ws + WS_X))
#define H ((bf16_t*)(ws + WS_H))
#define gcnt ((unsigned*)(ws + WS_CTL) + CW_MOECNT)
#define modF (MOD + 3 * 8 * 3072)

    for (int rep_pro = 0; rep_pro < PROBE_REP_PRO; ++rep_pro)
    if (IN(PH_PRO)) { PHV
        for (int i = bid * 512 + tid; i < S * 8; i += G * 512) { const int pos = i >> 3, j = i & 7;
            const float inv = powf(500000.0f, -(float)(2 * j) / 16.0f); const float ang = (float)pos * inv; ROPEC[i] = cosf(ang); ROPES[i] = sinf(ang); }
        LAS float* red = (LAS float*)(lds + 8 * 8448); LAS float* act = (LAS float*)(lds + 8 * 8448 + 16384);
        if (bid < 192) { const int ls = bid / 48, cb = bid % 48;
            const float* cp = in[I_C];
            for (int i = tid; i < 8 * D; i += 512) { const float v = cp[i]; act[i] = v / (1.f + __expf(-v)); }
            __syncthreads();
            gemv_item<8>(act, in[I_ADA_W] + (size_t)ls * D * 3072, 3072, D, cb * 64, in[I_ADA_B] + ls * 3072, MOD + (size_t)ls * 8 * 3072, 3072, red, wave, lane); }
        else if (bid < 200) { const int it = bid - 192, mat = it >> 2, cb = it & 3;
            const float* pe = in[I_NSA_CMP_PE];
            for (int i = tid; i < 2048; i += 512) act[i] = pe[i];
            __syncthreads();
            gemv_item<1>(act, mat ? in[I_NSA_CMP_V1] : in[I_NSA_CMP_K1], 256, 2048, cb * 64, nullptr, BIASKV + mat * 256, 0, red, wave, lane); }
        {
            float* TMPQ = (float*)(ws + WS_TMPQ); float* TMPO = (float*)(ws + WS_TMPO);
            const float* wuq = in[I_DSA_W_UQ]; const float* wuk = in[I_DSA_W_UK]; const float* wuv = in[I_DSA_W_UV]; const float* wo = in[I_DSA_W_O];
            for (int i = bid * 512 + tid; i < 256 * 2048; i += G * 512) { const int k = i >> 11, hc = i & 2047, h = hc >> 7;
                f32x4 qa[12], ka[12];
#pragma unroll
                for (int j = 0; j < 12; ++j) { qa[j] = ldg16f(wuq + (size_t)k * 1024 + h * 64 + 16 + 4 * j); ka[j] = ldg16f(wuk + (size_t)hc * 48 + 4 * j); }
                float a = 0.f;
#pragma unroll
                for (int j = 0; j < 12; ++j) a += (qa[j][0] * ka[j][0] + qa[j][1] * ka[j][1]) + (qa[j][2] * ka[j][2] + qa[j][3] * ka[j][3]);
                TMPQ[i] = a; }
            for (int i = bid * 512 + tid; i < 2048 * 256; i += G * 512) { const int hc = i >> 8, n4 = i & 255, h = hc >> 7;
                f32x4 acc = {0.f, 0.f, 0.f, 0.f};
                const float* wop = wo + (size_t)(h * 64) * 1024 + 4 * n4; const float* wvp = wuv + (size_t)hc * 64;
#pragma unroll 1
                for (int vb = 0; vb < 4; ++vb, wop += 16 * 1024, wvp += 16) {
                    f32x4 wv4[4], wo16[16];
#pragma unroll
                    for (int j = 0; j < 4; ++j) wv4[j] = ldg16f(wvp + 4 * j);
#pragma unroll
                    for (int j = 0; j < 16; ++j) wo16[j] = ldg16f(wop + (size_t)j * 1024);
#pragma unroll
                    for (int j = 0; j < 16; ++j) acc = acc + wo16[j] * wv4[j >> 2][j & 3];
                }
                *(GAS f32x4*)(TMPO + (size_t)hc * 1024 + 4 * n4) = acc; }
        }
        conv_items(F13{in[I_FFN_W1], in[I_FFN_W3], FF}, 2 * FF, 1024, (bf16_t*)(ws + WS_W13), scr, gw, NGW, lane);
        conv_items(FPlain{in[I_FFN_W2], D}, D, FF, (bf16_t*)(ws + WS_W2), scr, gw, NGW, lane);
        conv_items(FNin{in[I_NSA_W_IN]}, FF, 1024, (bf16_t*)(ws + WS_WNIN), scr, gw, NGW, lane);
        conv_items(FPlain{in[I_NSA_W_O], D}, D, D, (bf16_t*)(ws + WS_WNWO), scr, gw, NGW, lane);
        conv_items(FIn0{in[I_DSA_W_IN]}, 512, 1024, (bf16_t*)(ws + WS_WIN0), scr, gw, NGW, lane);
        conv_items(FK1{in[I_NSA_CMP_K1]}, 256, 2048, (bf16_t*)(ws + WS_WK1), scr, gw, NGW, lane);
        conv_items(FPlain{in[I_NSA_CMP_V1], 256}, 256, 2048, (bf16_t*)(ws + WS_WV1), scr, gw, NGW, lane);
        conv_items(FK2V2{in[I_NSA_CMP_K2], in[I_NSA_CMP_V2]}, 256, 512, (bf16_t*)(ws + WS_WK2V2), scr, gw, NGW, lane);
        GRID_BAR();
    }
    if (IN(PH_MOD0)) { PHV
        conv_items(FQ{in[I_DSA_W_UQ], in[I_DSA_W_IQ], (const float*)(ws + WS_TMPQ)}, 3072, 256, (bf16_t*)(ws + WS_WQ), scr, gw, NGW, lane);
        conv_items(FPlain{(const float*)(ws + WS_TMPO), D}, D, 2048, (bf16_t*)(ws + WS_WOC), scr, gw, NGW, lane);
        mod_rows(in[I_X], in[I_NORM_MIX], MOD, H, gw, NGW, lane);
        GRID_BAR();
    }
    if (IN(PH_IN0)) { PHV
        pg8::Gemm g{(const char*)H, (const char*)(ws + WS_WIN0), 1024, 2048u, 128u}; pg8::StaticOrder So; So.init(T / 256, 2, G, bid);
        pg8::EpiF32 E{(float*)(ws + WS_PROJ0), 512};
        pg8::gemm_phase<pg8::EpiF32, pg8::MapLinear>(lds, g, So, E, tid);
        GRID_BAR();
    }
    if (IN(PH_DPOST)) { PHV
        dsa_post_rows((const float*)(ws + WS_PROJ0), in[I_DSA_G_Q], in[I_DSA_G_KV], ROPEC, ROPES, (bf16_t*)(ws + WS_QLN), (bf16_t*)(ws + WS_KCAT), (bf16_t*)(ws + WS_IK), (float*)(ws + WS_IW), gw, NGW, lane);
        GRID_BAR();
    }
    if (IN(PH_Q)) { PHV
        { pg8::Gemm g{(const char*)(ws + WS_QLN), (const char*)(ws + WS_WQ), 256, 512u, 128u}; pg8::StaticOrder So; So.init(T / 256, 10, G, bid);
          pg8::EpiQ<true> E{(bf16_t*)(ws + WS_QCAT), ROPEC, ROPES};
          pg8::gemm_phase<pg8::EpiQ<true>, pg8::MapLinear>(lds, g, So, E, tid); }
        { PHV pg8::Gemm g{(const char*)(ws + WS_QLN), (const char*)(ws + WS_WQ) + (size_t)2560 * 256 * 2, 256, 512u, 128u}; pg8::StaticOrder So; So.init(T / 256, 2, G, bid);
          pg8::EpiQ<false> E{(bf16_t*)(ws + WS_IQ), ROPEC, ROPES};
          pg8::gemm_phase<pg8::EpiQ<false>, pg8::MapLinear>(lds, g, So, E, tid); }
        GRID_BAR();
    }
    if (IN(PH_DSA)) { PHV
        dsa_core((const bf16_t*)(ws + WS_IQ), (const bf16_t*)(ws + WS_IK), (const float*)(ws + WS_IW), (const bf16_t*)(ws + WS_QCAT), (const bf16_t*)(ws + WS_KCAT), (bf16_t*)(ws + WS_OLAT), lds, bid, G, wave, lane);
        GRID_BAR();
    }
#if PROBE_REP_DSA > 1
    if (IN(PH_DSA)) { PHV
        dsa_core((const bf16_t*)(ws + WS_IQ), (const bf16_t*)(ws + WS_IK), (const float*)(ws + WS_IW), (const bf16_t*)(ws + WS_QCAT), (const bf16_t*)(ws + WS_KCAT), (bf16_t*)(ws + WS_OLAT), lds, bid, G, wave, lane);
        GRID_BAR();
    }
#endif
    if (IN(PH_WO0)) { PHV
        pg8::Gemm g{(const char*)(ws + WS_OLAT), (const char*)(ws + WS_WOC), 2048, 4096u, 128u}; pg8::StaticOrder So; So.init(T / 256, 4, G, bid);
        pg8::EpiResid E{in[I_X], X, MOD + 0 * 8 * 3072 + 2048, PROBE_DSA_SCALE};
        pg8::gemm_phase<pg8::EpiResid, pg8::MapLinear>(lds, g, So, E, tid);
        GRID_BAR();
    }
    if (IN(PH_MOD1)) { PHV mod_rows(X, in[I_NORM_FFN], MOD + 1 * 8 * 3072, H, gw, NGW, lane); GRID_BAR(); }
    if (IN(PH_UP)) { PHV
        pg8::Gemm g{(const char*)H, (const char*)(ws + WS_W13), 1024, 2048u, 128u}; pg8::StaticOrder So; So.init(T / 256, 22, G, bid);
        pg8::EpiSwiglu E{(bf16_t*)(ws + WS_U), FF};
        pg8::gemm_phase<pg8::EpiSwiglu, pg8::MapLinear>(lds, g, So, E, tid);
        GRID_BAR();
    }
    if (IN(PH_DOWN)) { PHV
        pg8::Gemm g{(const char*)(ws + WS_U), (const char*)(ws + WS_W2), FF, (unsigned)(FF * 2), 128u}; pg8::StaticOrder So; So.init(T / 256, 4, G, bid);
        pg8::EpiResid E{X, X, MOD + 1 * 8 * 3072 + 2048, 1.f};
        pg8::gemm_phase<pg8::EpiResid, pg8::MapLinear>(lds, g, So, E, tid);
        GRID_BAR();
    }
    if (IN(PH_MOD2)) { PHV mod_rows(X, in[I_NORM_MIX] + D, MOD + 2 * 8 * 3072, H, gw, NGW, lane); GRID_BAR(); }
    if (IN(PH_NIN)) { PHV
        pg8::Gemm g{(const char*)H, (const char*)(ws + WS_WNIN), 1024, 2048u, 128u}; pg8::StaticOrder So; So.init(T / 256, 10, G, bid);
        pg8::EpiNsaIn E{(bf16_t*)(ws + WS_PROJ1), (float*)(ws + WS_GATES), ROPEC, ROPES};
        pg8::gemm_phase<pg8::EpiNsaIn, pg8::MapLinear>(lds, g, So, E, tid);
        GRID_BAR();
    }
    if (IN(PH_CMP1)) {
        { PHV pg8::Gemm g{(const char*)(ws + WS_PROJ1) + 1024 * 2, (const char*)(ws + WS_WK1), 2048, (unsigned)(FF * 2), (unsigned)(FF * 2)}; pg8::StaticOrder So; So.init(32, 1, G, bid);
          pg8::EpiCmpH E{(bf16_t*)(ws + WS_CMPH), BIASKV, 0};
          pg8::gemm_phase<pg8::EpiCmpH, pg8::MapCmp>(lds, g, So, E, tid); }
        { PHV pg8::Gemm g{(const char*)(ws + WS_PROJ1) + 1280 * 2, (const char*)(ws + WS_WV1), 2048, (unsigned)(FF * 2), (unsigned)(FF * 2)}; pg8::StaticOrder So; So.init(32, 1, G, (bid + 224) % G);
          pg8::EpiCmpH E{(bf16_t*)(ws + WS_CMPH), BIASKV + 256, 256};
          pg8::gemm_phase<pg8::EpiCmpH, pg8::MapCmp>(lds, g, So, E, tid); }
        { PHV pg8::Gemm g{(const char*)H, (const char*)(ws + WS_WNIN) + (size_t)10 * 256 * 1024 * 2, 1024, 2048u, 128u}; pg8::StaticOrder So; So.init(T / 256, 1, G, (bid + 192) % G);
          pg8::EpiNsaGate E{(float*)(ws + WS_GATES)};
          pg8::gemm_phase<pg8::EpiNsaGate, pg8::MapLinear>(lds, g, So, E, tid); }
        GRID_BAR();
    }
    if (IN(PH_CMP2)) { PHV
        pg8::Gemm g{(const char*)(ws + WS_CMPH), (const char*)(ws + WS_WK2V2), 512, 1024u, 128u}; pg8::StaticOrder So; So.init(32, 1, G, bid);
        pg8::EpiCmpO E{(bf16_t*)(ws + WS_KVCMP)};
        pg8::gemm_phase<pg8::EpiCmpO, pg8::MapLinear>(lds, g, So, E, tid);
        GRID_BAR();
    }
    if (IN(PH_NSA)) { PHV
        nsa_core((const bf16_t*)(ws + WS_PROJ1), (const bf16_t*)(ws + WS_KVCMP), (const float*)(ws + WS_GATES), (bf16_t*)(ws + WS_ONSA), lds, bid, G, wave, lane);
        GRID_BAR();
    }
#if PROBE_REP_NSA > 1
    if (IN(PH_NSA)) { PHV
        nsa_core((const bf16_t*)(ws + WS_PROJ1), (const bf16_t*)(ws + WS_KVCMP), (const float*)(ws + WS_GATES), (bf16_t*)(ws + WS_ONSA), lds, bid, G, wave, lane);
        GRID_BAR();
    }
#endif
    if (IN(PH_WO1)) { PHV
        pg8::Gemm g{(const char*)(ws + WS_ONSA), (const char*)(ws + WS_WNWO), 1024, 2048u, 128u}; pg8::StaticOrder So; So.init(T / 256, 4, G, bid);
        pg8::EpiResid E{X, X, MOD + 2 * 8 * 3072 + 2048, PROBE_NSA_SCALE};
        pg8::gemm_phase<pg8::EpiResid, pg8::MapLinear>(lds, g, So, E, tid);
        GRID_BAR();
    }
    if (IN(PH_ROUTE)) { PHV
        moe_route(X, in[I_NORM_FFN] + D, modF, in[I_MOE_ROUTER], gcnt, (int*)(ws + WS_ROUTEE), (float*)(ws + WS_ROUTEG), lds, bid, G, wave, lane);
        GRID_BAR();
    }
    if (IN(PH_FILL)) { PHV
        moe_fill(X, in[I_NORM_FFN] + D, modF, gcnt, (const int*)(ws + WS_ROUTEE), (const float*)(ws + WS_ROUTEG), (bf16_t*)(ws + WS_AMOE), (int*)(ws + WS_SLOTTOK), (float*)(ws + WS_SLOTGATE), gw, NGW, lane);
        int e = 0, t0 = 0, nt = 0; if (moe_chunk(gcnt, 0, e, t0, nt))
            conv_items(F13{in[I_MOE_W1] + (size_t)e * D * ED, in[I_MOE_W3] + (size_t)e * D * ED, ED}, 2 * ED, 1024, (bf16_t*)(ws + WS_W13M), scr, gw, NGW, lane);
        GRID_BAR();
    }
    for (int rep_moe = 0; rep_moe < PROBE_REP_MOE; ++rep_moe)
    for (int r = 0; r < PH_MOE_N; ++r) {
        if (!IN(PH_MOE0 + r)) continue;
        { unsigned char* ws = ws_p; if (r > moe_nchunks(gcnt)) continue; }
        int cv_rank, cv_n, e13, e2, n13, n2;
        { unsigned char* ws = ws_p; int e1 = 0, ta = 0, ntp = 0, ntc = 0; const int Gc = gridDim.x, bidc = blockIdx.x;
          const int nd = (r > 0 && moe_chunk(gcnt, r - 1, e1, ta, ntp)) ? ntp * 4 : 0; const int nu = moe_chunk(gcnt, r, e1, ta, ntc) ? ntc * 28 : 0;
          const int per2 = (7 * nd + 2 * nu) / Gc; int ud = (per2 - 7 + 1) / 2; if (ud < 0) ud = 0; if (nd > 0 && ud * nd > nu) ud = nu / nd;
          const int R = nu - nd * ud, nrest = Gc - nd; const int rem = (nrest > 0 && R > 0) ? R % nrest : 0;
          n13 = moe_chunk(gcnt, r + 1, e1, ta, ntc) ? (2 * ED / 32) * (1024 / 64) : 0; n2 = (nu > 0) ? (D / 32) * (ED / 64) : 0;
          cv_n = (MOE_CONV_SLACK && rem > 0) ? nrest - rem : 0; cv_rank = (cv_n > 0 && bidc >= nd + rem) ? bidc - nd - rem : -1;
          int etot = cv_n * 8 * MOE_CONV_ROUNDS; if (etot > n13 + n2) etot = n13 + n2; e13 = etot < n13 ? etot : n13; e2 = etot - e13;
        }
        { PHV int e = 0, t0 = 0, nt = 0;
          if (n13 > e13 && moe_chunk(gcnt, r + 1, e, t0, nt))
              conv_range(F13{in[I_MOE_W1] + (size_t)e * D * ED, in[I_MOE_W3] + (size_t)e * D * ED, ED}, 2 * ED, 1024, (bf16_t*)(ws + WS_W13M + ((r + 1) & 1) * W13M_BYTES), scr, e13, n13, gw, NGW, lane); }
        { PHV int e = 0, t0 = 0, nt = 0;
          if (n2 > e2 && moe_chunk(gcnt, r, e, t0, nt))
              conv_range(FPlain{in[I_MOE_W2] + (size_t)e * ED * D, D}, D, ED, (bf16_t*)(ws + WS_W2M + (r & 1) * W2M_BYTES), scr, e2, n2, gw, NGW, lane); }
        __syncthreads();
        { PHV int e = 0, t0 = 0, nt = 0;
          if (r > 0 && moe_chunk(gcnt, r - 1, e, t0, nt)) {
              pg8::Gemm g{(const char*)(ws + WS_HID + ((r - 1) & 1) * HID_BYTES), (const char*)(ws + WS_W2M + ((r - 1) & 1) * W2M_BYTES), ED, (unsigned)(ED * 2), 128u};
              pg8::ListOrder So; So.nN = 4; So.total = nt * 4; So.first = bid; So.nfirst = 1; So.start2 = So.total; So.stride2 = 0;
              pg8::EpiMoeDown E{X, modF + 2048, (const int*)(ws + WS_SLOTTOK), (const float*)(ws + WS_SLOTGATE), t0 * 256, (rep_moe == 0) ? 1.f : 0.f};
              pg8::gemm_phase<pg8::EpiMoeDown, pg8::MapLinear, pg8::ListOrder>(lds, g, So, E, tid); } }
        { PHV int e = 0, t0 = 0, nt = 0, e2 = 0, t2 = 0, nt2 = 0;
          if (!moe_chunk(gcnt, r, e, t0, nt) && r > 0 && moe_chunk(gcnt, r - 1, e2, t2, nt2)) {
              const int nd = nt2 * 4;
              if (bid >= nd && nd < G) final_rows_subset(X, in[I_FINAL_NORM], out_p, (const int*)(ws + WS_ROUTEE), e2, false, (bid - nd) * 8 + wave, (G - nd) * 8, lane);
          } }
        { PHV int e = 0, t0 = 0, nt = 0;
          if (moe_chunk(gcnt, r, e, t0, nt)) {
              pg8::Gemm g{(const char*)(ws + WS_AMOE) + (size_t)t0 * 256 * D * 2, (const char*)(ws + WS_W13M + (r & 1) * W13M_BYTES), 1024, 2048u, 128u};
              int e2 = 0, t2 = 0, nt2 = 0; const int nd = (r > 0 && moe_chunk(gcnt, r - 1, e2, t2, nt2)) ? nt2 * 4 : 0;
              const int nu = nt * 28; const int per2 = (7 * nd + 2 * nu) / G;
              int ud = (per2 - 7 + 1) / 2; if (ud < 0) ud = 0; if (nd > 0 && ud * nd > nu) ud = nu / nd; if (nd >= G) ud = (nu + G - 1) / G;
              pg8::ListOrder So; So.nN = 28; So.total = nu;
              if (bid < nd) { So.first = bid * ud; So.nfirst = ud; So.start2 = nu; So.stride2 = 0; }
              else { So.first = 0; So.nfirst = 0; So.start2 = nd * ud + (bid - nd); So.stride2 = G - nd; }
              pg8::EpiSwiglu E{(bf16_t*)(ws + WS_HID + (r & 1) * HID_BYTES), ED};
              pg8::gemm_phase<pg8::EpiSwiglu, pg8::MapLinear, pg8::ListOrder>(lds, g, So, E, tid); } }
        if (cv_rank >= 0) {
            __syncthreads();
            { PHV int e = 0, t0 = 0, nt = 0;
              if (e13 > 0 && moe_chunk(gcnt, r + 1, e, t0, nt))
                  conv_range(F13{in[I_MOE_W1] + (size_t)e * D * ED, in[I_MOE_W3] + (size_t)e * D * ED, ED}, 2 * ED, 1024, (bf16_t*)(ws + WS_W13M + ((r + 1) & 1) * W13M_BYTES), scr, 0, e13, cv_rank * 8 + wave, cv_n * 8, lane); }
            { PHV int e = 0, t0 = 0, nt = 0;
              if (e2 > 0 && moe_chunk(gcnt, r, e, t0, nt))
                  conv_range(FPlain{in[I_MOE_W2] + (size_t)e * ED * D, D}, D, ED, (bf16_t*)(ws + WS_W2M + (r & 1) * W2M_BYTES), scr, 0, e2, cv_rank * 8 + wave, cv_n * 8, lane); }
        }
        GRID_BAR();
    }
    if (IN(PH_FINAL)) { PHV
        const int nchf = moe_nchunks(gcnt); int e2 = 0, t2 = 0, nt2 = 0;
        const bool early = nchf > 0 && moe_chunk(gcnt, nchf - 1, e2, t2, nt2) && (nt2 * 4 < G);
        if (early) final_rows_subset(X, in[I_FINAL_NORM], out_p, (const int*)(ws + WS_ROUTEE), e2, true, gw, NGW, lane);
        else final_rows(X, in[I_FINAL_NORM], out_p, gw, NGW, lane);
    }
#undef IN
}

extern "C" void kernel_launch(void* const* d_in, const int* in_sizes, int n_in, void* d_out, int out_size, void* d_ws, size_t ws_size, hipStream_t stream) {
    static int grid = 0;
    if (grid == 0) {
        if (n_in != 29 || in_sizes[0] != T * D || out_size != T * D || ws_size < WS_END) { fprintf(stderr, "kernel_launch: unexpected shapes (n_in %d in0 %d out %d ws %zu)\n", n_in, n_in > 0 ? in_sizes[0] : -1, out_size, ws_size); grid = -1; return; }
        int dev = 0, cus = 0, per_cu = 0;
        if (hipGetDevice(&dev) != hipSuccess || hipDeviceGetAttribute(&cus, hipDeviceAttributeMultiprocessorCount, dev) != hipSuccess) { grid = -1; return; }
        if (hipFuncSetAttribute((const void*)fwd_kernel, hipFuncAttributeMaxDynamicSharedMemorySize, LDS_BYTES) != hipSuccess) { fprintf(stderr, "kernel_launch: hipFuncSetAttribute failed\n"); grid = -1; return; }
        if (hipOccupancyMaxActiveBlocksPerMultiprocessor(&per_cu, (const void*)fwd_kernel, 512, LDS_BYTES) != hipSuccess || per_cu < 1) fprintf(stderr, "kernel_launch: occupancy query reports %d\n", per_cu);
        (void)hipGetLastError();
        grid = cus;
    }
    if (grid < 0) return;
    if (hipMemsetAsync((char*)d_ws + WS_CTL, 0, CTL_BYTES, stream) != hipSuccess) return;
    const float* ip[29];
    for (int i = 0; i < 29; ++i) ip[i] = (const float*)d_in[i];
#define KARGS ip[0], ip[1], ip[2], ip[3], ip[4], ip[5], ip[6], ip[7], ip[8], ip[9], ip[10], ip[11], ip[12], ip[13], ip[14], ip[15], ip[16], ip[17], ip[18], ip[19], ip[20], ip[21], ip[22], ip[23], ip[24], ip[25], ip[26], ip[27], ip[28], (float*)d_out, (unsigned char*)d_ws
#if MK_SPLIT
    for (int p = 0; p < PH_COUNT; ++p) hipLaunchKernelGGL(fwd_kernel, dim3(grid), dim3(512), LDS_BYTES, stream, KARGS, p, p + 1);
#else
    hipLaunchKernelGGL(fwd_kernel, dim3(grid), dim3(512), LDS_BYTES, stream, KARGS, 0, (int)PH_COUNT);
#endif
}
```

```cpp
#include <hip/hip_runtime.h>
#include <cstdio>
#include <cstdint>
#include <cmath>

#ifndef PROBE_DSA_SCALE
#define PROBE_DSA_SCALE 1.f
#endif
#ifndef PROBE_NSA_SCALE
#define PROBE_NSA_SCALE 1.f
#endif
#ifndef PROBE_REP_DSA
#define PROBE_REP_DSA 1
#endif
#ifndef PROBE_REP_NSA
#define PROBE_REP_NSA 1
#endif
#ifndef PROBE_REP_A
#define PROBE_REP_A 1
#endif
#ifndef PROBE_REP_C
#define PROBE_REP_C 1
#endif
#ifndef PROBE_REP_B
#define PROBE_REP_B 1
#endif
#ifndef MOE_CONV_SLACK
#define MOE_CONV_SLACK 1
#define MOE_CONV_ROUNDS 7
#endif
#ifndef PROBE_REP_MOE
#define PROBE_REP_MOE 1
#endif
#ifndef PROBE_REP_PRO
#define PROBE_REP_PRO 1
#endif
#ifndef ONLY_PHASE
#define ONLY_PHASE -1
#endif
#define PH_EN(k) (ONLY_PHASE < 0 || ONLY_PHASE == (k) || (ONLY_PHASE >= 100 && (k) >= ONLY_PHASE - 100 && (k) < ONLY_PHASE - 100 + 14))
#ifndef MK_SPLIT
#define MK_SPLIT 0
#endif

#define LAS __attribute__((address_space(3)))
#define GAS __attribute__((address_space(1)))
typedef unsigned short bf16_t;
typedef short bf16x8 __attribute__((ext_vector_type(8)));
typedef short s16x4 __attribute__((ext_vector_type(4)));
typedef float f32x2 __attribute__((ext_vector_type(2)));
typedef float f32x4 __attribute__((ext_vector_type(4)));
typedef float f32x16 __attribute__((ext_vector_type(16)));
typedef unsigned u32x2 __attribute__((ext_vector_type(2)));
typedef unsigned u32x4 __attribute__((ext_vector_type(4)));
typedef __bf16 bf16x2_t __attribute__((ext_vector_type(2)));
typedef short v4i16_t __attribute__((ext_vector_type(4)));

__device__ __forceinline__ unsigned cvtpk(float lo, float hi) { f32x2 v = {lo, hi}; bf16x2_t b = __builtin_convertvector(v, bf16x2_t); return __builtin_bit_cast(unsigned, b); }
#define WS_DPPF(v, ctrl, rmask) v += __int_as_float(__builtin_amdgcn_update_dpp(0, __float_as_int(v), ctrl, rmask, 0xF, false))
__device__ __forceinline__ float wave_sum(float v) {
    WS_DPPF(v, 0x111, 0xF); WS_DPPF(v, 0x112, 0xF); WS_DPPF(v, 0x114, 0xF); WS_DPPF(v, 0x118, 0xF); WS_DPPF(v, 0x142, 0xA); WS_DPPF(v, 0x143, 0xC);
    return __int_as_float(__builtin_amdgcn_readlane(__float_as_int(v), 63));
}
#undef WS_DPPF
__device__ __forceinline__ int wave_sum_i(int v) {
    v += __builtin_amdgcn_update_dpp(0, v, 0x111, 0xF, 0xF, false); v += __builtin_amdgcn_update_dpp(0, v, 0x112, 0xF, 0xF, false);
    v += __builtin_amdgcn_update_dpp(0, v, 0x114, 0xF, 0xF, false); v += __builtin_amdgcn_update_dpp(0, v, 0x118, 0xF, 0xF, false);
    v += __builtin_amdgcn_update_dpp(0, v, 0x142, 0xA, 0xF, false); v += __builtin_amdgcn_update_dpp(0, v, 0x143, 0xC, 0xF, false);
    return __builtin_amdgcn_readlane(v, 63);
}

__device__ __forceinline__ int wave_scan_incl_i(int v) {
    v += __builtin_amdgcn_update_dpp(0, v, 0x111, 0xF, 0xF, false); v += __builtin_amdgcn_update_dpp(0, v, 0x112, 0xF, 0xF, false);
    v += __builtin_amdgcn_update_dpp(0, v, 0x114, 0xF, 0xF, false); v += __builtin_amdgcn_update_dpp(0, v, 0x118, 0xF, 0xF, false);
    v += __builtin_amdgcn_update_dpp(0, v, 0x142, 0xA, 0xF, false); v += __builtin_amdgcn_update_dpp(0, v, 0x143, 0xC, 0xF, false);
    return v;
}
__device__ __forceinline__ int wave_total_i(int v) { return __builtin_amdgcn_readlane(wave_scan_incl_i(v), 63); }
__device__ __forceinline__ unsigned wave_max_u(unsigned v) {
    unsigned t;
    t = (unsigned)__builtin_amdgcn_update_dpp(0, (int)v, 0x111, 0xF, 0xF, false); v = t > v ? t : v; t = (unsigned)__builtin_amdgcn_update_dpp(0, (int)v, 0x112, 0xF, 0xF, false); v = t > v ? t : v;
    t = (unsigned)__builtin_amdgcn_update_dpp(0, (int)v, 0x114, 0xF, 0xF, false); v = t > v ? t : v; t = (unsigned)__builtin_amdgcn_update_dpp(0, (int)v, 0x118, 0xF, 0xF, false); v = t > v ? t : v;
    t = (unsigned)__builtin_amdgcn_update_dpp(0, (int)v, 0x142, 0xA, 0xF, false); v = t > v ? t : v; t = (unsigned)__builtin_amdgcn_update_dpp(0, (int)v, 0x143, 0xC, 0xF, false); v = t > v ? t : v;
    return (unsigned)__builtin_amdgcn_readlane((int)v, 63);
}
__device__ __forceinline__ float fast_exp2(float x) { return __builtin_amdgcn_exp2f(x); }
__device__ __forceinline__ float fast_rcp(float x) { return __builtin_amdgcn_rcpf(x); }
__device__ __forceinline__ float silu_f(float a) { return a * fast_rcp(1.f + fast_exp2(-1.4426950408889634f * a)); }
__device__ __forceinline__ float sigmoid_f(float a) { return fast_rcp(1.f + fast_exp2(-1.4426950408889634f * a)); }
__device__ __forceinline__ u32x4 ldg16(const void* p) { return *(const GAS u32x4*)p; }
__device__ __forceinline__ bf16x8 ldg16h(const void* p) { return *(const GAS bf16x8*)p; }
__device__ __forceinline__ f32x4 ldg16f(const void* p) { return *(const GAS f32x4*)p; }
__device__ __forceinline__ void stg16(void* p, u32x4 v) { *(GAS u32x4*)p = v; }
__device__ __forceinline__ void stg8(void* p, u32x2 v) { *(GAS u32x2*)p = v; }
__device__ __forceinline__ int rp16(int j) { return (j >> 1) + 8 * (j & 1); }

constexpr int T = 32768, S = 4096, D = 1024, NB = 8;
constexpr int FF = 2816, ED = 3584, NE = 8;
constexpr int DSA_IN = 472, NSA_IN = 2608;
constexpr float EPS = 1e-6f;
constexpr float C2 = 0.125f * 1.4426950408889634f;
constexpr float LOG2E = 1.4426950408889634f;

constexpr size_t MiB = 1u << 20;
constexpr size_t WS_CTL = 0, CTL_BYTES = 65536;
constexpr size_t WS_MOD = 1 * MiB;
constexpr size_t WS_ROPEC = 1 * MiB + 512 * 1024;
constexpr size_t WS_ROPES = 1 * MiB + 640 * 1024;
constexpr size_t WS_BIASKV = 1 * MiB + 768 * 1024;
constexpr size_t WS_WIN0 = 4 * MiB, WS_WQ = 5 * MiB, WS_WOC = 7 * MiB, WS_W13 = 11 * MiB, WS_W2 = 22 * MiB, WS_WNIN = 28 * MiB;
constexpr size_t WS_WK1 = 34 * MiB, WS_WV1 = 35 * MiB, WS_WK2V2 = 36 * MiB, WS_WNWO = 37 * MiB;
constexpr size_t WS_X = 40 * MiB;
constexpr size_t WS_H = 168 * MiB, WS_PROJ0 = 232 * MiB, WS_OLAT = 168 * MiB, WS_ONSA = 232 * MiB, WS_AMOE = 168 * MiB;
constexpr size_t WS_QLN = 296 * MiB, WS_KCAT = 312 * MiB, WS_IK = 322 * MiB, WS_IW = 326 * MiB, WS_QCAT = 328 * MiB, WS_IQ = 488 * MiB;
constexpr size_t WS_TMPQ = 396 * MiB, WS_TMPO = 400 * MiB;
constexpr size_t WS_U = 296 * MiB;
constexpr size_t WS_PROJ1 = 296 * MiB, WS_GATES = 472 * MiB, WS_CMPH = 478 * MiB, WS_KVCMP = 486 * MiB;
constexpr size_t WS_W13M = 300 * MiB, WS_W2M = 328 * MiB, WS_HID = 342 * MiB;
constexpr size_t W13M_BYTES = 14 * MiB, W2M_BYTES = 7 * MiB;
constexpr int CAPT = 48;
constexpr size_t HID_BYTES = (size_t)CAPT * 256 * ED * 2;
constexpr size_t WS_SLOTTOK = 510 * MiB, WS_SLOTGATE = 510 * MiB + 512 * 1024, WS_ROUTEE = 511 * MiB, WS_ROUTEG = 511 * MiB + 512 * 1024;
constexpr size_t WS_END = 520 * MiB;
static_assert(WS_HID + 2 * HID_BYTES <= WS_SLOTTOK, "ws map");
constexpr int AMOE_ROWS = 2 * T + NE * 256;
static_assert(WS_AMOE + (size_t)AMOE_ROWS * D * 2 <= WS_W13M, "ws map amoe");

constexpr int CW_BAR = 4096;
constexpr int CW_MOECNT = 8192;

constexpr int LDS_BYTES = 147456;
constexpr int LDS_MISC = 146432;

#define XB_TMO      128
#define XB_XCNT(j)  (256  + 64 * (j))
#define XB_XSUB(j)  (1280 + 64 * (j))
#define XB_XGEN(j)  (2304 + 64 * (j))
#define XB_TOP      3328
#define XB_TOPGEN   3392
#define XCD_BAR_WORDS 3456
#define XB_SPIN_CAP (1u << 22)

__device__ __forceinline__ unsigned xb_ld(unsigned* p)              { return __hip_atomic_load(p, __ATOMIC_RELAXED, __HIP_MEMORY_SCOPE_AGENT); }
__device__ __forceinline__ unsigned xb_add(unsigned* p, unsigned v) { return __hip_atomic_fetch_add(p, v, __ATOMIC_RELAXED, __HIP_MEMORY_SCOPE_AGENT); }
__device__ __forceinline__ unsigned xb_xcc_id() { return (unsigned)__builtin_amdgcn_s_getreg((3 << 11) | 20) & 0xFu; }
#define XB_SPIN(cond, bar) do { unsigned _sp = 0; while (cond) { __builtin_amdgcn_s_sleep(1); \
    if ((++_sp & 255u) == 0u) { if (xb_ld(&(bar)[XB_TMO])) break; if (_sp > XB_SPIN_CAP) { atomicAdd(&(bar)[XB_TMO], 1u); break; } } } } while (0)

struct XcdBarrier { unsigned* bar; unsigned x; volatile LAS unsigned* st; };

__device__ __forceinline__ XcdBarrier xcd_barrier_post(unsigned* bar, volatile LAS unsigned* st) {
    XcdBarrier b; b.bar = bar; b.x = xb_xcc_id(); b.st = st;
    if (threadIdx.x == 0) (void)xb_add(&bar[XB_XCNT(b.x)], 1u);
    return b;
}
__device__ __forceinline__ void xcd_barrier_complete(unsigned* bar, unsigned x, unsigned& nloc, unsigned& nx) {
    const unsigned G = gridDim.x * gridDim.y * gridDim.z;
    unsigned sum, cnt, mine, sp = 0u;
    for (;;) {
        sum = 0u; cnt = 0u; mine = 0u;
#pragma unroll
        for (unsigned j = 0; j < 16; ++j) { const unsigned c = xb_ld(&bar[XB_XCNT(j)]); sum += c; cnt += (c > 0u) ? 1u : 0u; mine = (j == x) ? c : mine; }
        if (sum == G) break;
        __builtin_amdgcn_s_sleep(1);
        if ((++sp & 255u) == 0u) { if (xb_ld(&bar[XB_TMO])) break; if (sp > XB_SPIN_CAP) { atomicAdd(&bar[XB_TMO], 1u); break; } }
    }
    nloc = mine > 0u ? mine : 1u; nx = cnt > 0u ? cnt : 1u;
}
__device__ __forceinline__ void xcd_barrier(const XcdBarrier& b, bool leader_thread) {
    asm volatile("s_waitcnt vmcnt(0)" ::: "memory");
    __syncthreads();
    if (leader_thread) {
        unsigned* bar = b.bar;
        __builtin_amdgcn_s_waitcnt(0);
        unsigned nloc = b.st[0], nx = b.st[1];
        if (nloc == 0u) { xcd_barrier_complete(bar, b.x, nloc, nx); b.st[0] = nloc; b.st[1] = nx; }
        const unsigned old = xb_add(&bar[XB_XSUB(b.x)], 1u);
        const unsigned gen = old / nloc;
        if (old + 1u == (gen + 1u) * nloc) {
            __builtin_amdgcn_fence(__ATOMIC_RELEASE, "agent");
            asm volatile("s_waitcnt vmcnt(0)" ::: "memory");
            const unsigned og = xb_add(&bar[XB_TOP], 1u);
            const unsigned tg = og / nx;
            if (og + 1u == (tg + 1u) * nx) xb_add(&bar[XB_TOPGEN], 1u);
            else XB_SPIN(xb_ld(&bar[XB_TOPGEN]) == tg, bar);
            __builtin_amdgcn_fence(__ATOMIC_ACQUIRE, "agent");
            xb_add(&bar[XB_XGEN(b.x)], 1u);
            asm volatile("s_waitcnt vmcnt(0)" ::: "memory");
        } else {
            XB_SPIN(xb_ld(&bar[XB_XGEN(b.x)]) == gen, bar);
            __builtin_amdgcn_fence(__ATOMIC_ACQUIRE, "agent");
            asm volatile("s_waitcnt vmcnt(0)" ::: "memory");
        }
    }
    __syncthreads();
}

namespace pg8 {
constexpr int BM = 256, BK = 64, HALF = 128, HTB = HALF * BK * 2, STAGE_BYTES = 8 * HTB, NXCD = 8, WGM = 8;
__host__ __device__ __forceinline__ int lds_byte(int r, int c) { const int st = (r >> 4) * 2 + (c >> 5), rr = r & 15, cc = c & 31, ob = rr * 64 + cc * 2; return st * 1024 + (ob ^ (((ob >> 9) & 1) << 5)); }
__host__ __device__ __forceinline__ void stage_rc(int b, int& R, int& C) { const int st = b / 1024, sb = b % 1024, swz = sb ^ (((sb >> 9) & 1) << 5); R = (st >> 1) * 16 + swz / 64; C = (st & 1) * 32 + (swz % 64) / 2; }
__host__ __device__ __forceinline__ int perm32(int rho) { const int n = rho >> 4, i = rho & 15; return 8 * (i >> 2) + 4 * n + (i & 3); }

struct Unit { int pm, pn; };
struct Gemm { const char* A; const char* Bt; int K; unsigned lda_bytes; unsigned kstepA; };
struct MapLinear { static __device__ __forceinline__ size_t rowoff(int r, unsigned ldb) { return (size_t)r * ldb; } };
struct MapCmp { static __device__ __forceinline__ size_t rowoff(int r, unsigned ldb) { return (size_t)(r >> 2) * 16 * ldb + (size_t)(r & 3) * 128; } };

struct StaticOrder {
    int nM, nN, nwg, G, c;
    __device__ void init(int nM_, int nN_, int G_, int c_) { nM = nM_; nN = nN_; nwg = nM * nN; G = G_; c = c_; }
    __device__ bool next(int i, Unit& u) const {
        const long L = (long)i * G + c; if (L >= nwg) return false;
        int wgid = (int)L; { const int q = nwg / NXCD, r = nwg % NXCD, xcd = wgid % NXCD, off = wgid / NXCD; wgid = (xcd < r ? xcd * (q + 1) : r * (q + 1) + (xcd - r) * q) + off; }
        const int nig = WGM * nN, gid = wgid / nig, fm = gid * WGM, gsz = (nM - fm) < WGM ? (nM - fm) : WGM;
        u.pm = fm + ((wgid % nig) % gsz); u.pn = (wgid % nig) / gsz; return true;
    }
};

struct ListOrder {
    int nN, total, first, nfirst, start2, stride2;
    __device__ bool next(int i, Unit& u) const {
        int L; if (i < nfirst) L = first + i; else L = start2 + (i - nfirst) * stride2;
        if (L >= total || (i >= nfirst && stride2 <= 0)) return false;
        u.pm = L / nN; u.pn = L - u.pm * nN; return true;
    }
};
template <class Epi, class AMap, class Sched = StaticOrder>
__device__ __forceinline__ void gemm_phase(LAS unsigned char* lds, const Gemm g, const Sched& S, const Epi& E, int tid_in) {
    int tid_ = tid_in; asm volatile("" : "+v"(tid_));
    const int tid = tid_, wid = __builtin_amdgcn_readfirstlane(tid >> 6), lane = tid & 63, wr = wid >> 2, wc = wid & 3, fr = lane & 15, fq = lane >> 4;
    const int K = g.K, nt = K / BK;
    unsigned voffA[2], voffB[2];
#pragma unroll
    for (int i = 0; i < 2; ++i) { int R, C; stage_rc(tid * 16 + i * 8192, R, C); const int Rb = Epi::PERM ? ((R & ~31) + perm32(R & 31)) : R;
        voffA[i] = (unsigned)AMap::rowoff(R, g.lda_bytes) + (unsigned)C * 2u; voffB[i] = (unsigned)(Rb * K + C) * 2u; }
    const size_t kstepA = g.kstepA, kstepB = (size_t)(BK * 2);
    const size_t hstepA = AMap::rowoff(HALF, g.lda_bytes), tstepA = AMap::rowoff(BM, g.lda_bytes);
    const size_t hstepB = (size_t)HALF * K * 2, tstepB = 2 * hstepB;
    const unsigned ldsw = (unsigned)wid * 1024u;
    const int aoff = lds_byte(wr * 64 + fr, fq * 8), boff = lds_byte(wc * 32 + fr, fq * 8);
#define PG8_SA(b, h) (((b) * 2 + (h)) * HTB)
#define PG8_SB(b, h) ((4 + (b) * 2 + (h)) * HTB)
#define PG8_STAGE(bufoff, gbase, voff) do { _Pragma("unroll") for (int _i = 0; _i < 2; ++_i) \
        __builtin_amdgcn_global_load_lds((const unsigned*)((const char*)(gbase) + (voff)[_i]), (LAS unsigned*)(lds + (bufoff) + ldsw + _i * 8192), 16, 0, 0); } while (0)
#define PG8_LDA(dst, b, h) do { _Pragma("unroll") for (int m = 0; m < 4; ++m) _Pragma("unroll") for (int k = 0; k < 2; ++k) dst[m][k] = *(const LAS bf16x8*)(lds + PG8_SA(b, h) + aoff + m * 2048 + k * 1024); } while (0)
#define PG8_LDB(dst, b, h) do { _Pragma("unroll") for (int n = 0; n < 2; ++n) _Pragma("unroll") for (int k = 0; k < 2; ++k) dst[n][k] = *(const LAS bf16x8*)(lds + PG8_SB(b, h) + boff + n * 2048 + k * 1024); } while (0)
#define PG8_MMA(ai, bj, At, Bt) do { __builtin_amdgcn_s_setprio(1); _Pragma("unroll") for (int m = 0; m < 4; ++m) _Pragma("unroll") for (int n = 0; n < 2; ++n) _Pragma("unroll") for (int k = 0; k < 2; ++k) \
        acc[ai][bj][m][n] = __builtin_amdgcn_mfma_f32_16x16x32_bf16(Bt[n][k], At[m][k], acc[ai][bj][m][n], 0, 0, 0); __builtin_amdgcn_s_setprio(0); } while (0)
#define PG8_WAIT_V(n) asm volatile("s_waitcnt vmcnt(" #n ")" ::: "memory")
#define PG8_WAIT_L(n) asm volatile("s_waitcnt lgkmcnt(" #n ")" ::: "memory")
#define PG8_BAR __builtin_amdgcn_s_barrier()
#define PG8_SCHED __builtin_amdgcn_sched_barrier(0)
    Unit cur, nxt; int ui = 0;
    if (!S.next(0, cur)) return;
    f32x4 acc[2][2][4][2];
#pragma unroll
    for (int a = 0; a < 2; ++a)
#pragma unroll
        for (int b = 0; b < 2; ++b)
#pragma unroll
            for (int m = 0; m < 4; ++m)
#pragma unroll
                for (int n = 0; n < 2; ++n) acc[a][b][m][n] = (f32x4){0.f, 0.f, 0.f, 0.f};
    bf16x8 At[4][2], B0[2][2], B1[2][2];
    const char* cA = g.A + (size_t)cur.pm * tstepA; const char* cB = g.Bt + (size_t)cur.pn * tstepB;
    PG8_STAGE(PG8_SB(0, 0), cB, voffB); PG8_STAGE(PG8_SB(0, 1), cB + hstepB, voffB); PG8_STAGE(PG8_SA(0, 0), cA, voffA); PG8_STAGE(PG8_SA(0, 1), cA + hstepA, voffA);
    if (wr == 1) PG8_BAR;
    PG8_WAIT_V(2); PG8_BAR;
    PG8_STAGE(PG8_SB(1, 0), cB + kstepB, voffB); PG8_STAGE(PG8_SA(1, 0), cA + kstepA, voffA); PG8_STAGE(PG8_SB(1, 1), cB + hstepB + kstepB, voffB);
    PG8_WAIT_V(6); PG8_BAR;
    for (;;) {
        const bool has_next = S.next(ui + 1, nxt);
        const char* nA = has_next ? g.A + (size_t)nxt.pm * tstepA : cA; const char* nB = has_next ? g.Bt + (size_t)nxt.pn * tstepB : cB;
#pragma nounroll
        for (int t = 0; t < nt; t += 2) {
            const bool last = (t == nt - 2);
            const char* a1 = cA + (size_t)(t + 1) * kstepA;
            const char* a2 = last ? nA : cA + (size_t)(t + 2) * kstepA; const char* b2 = last ? nB : cB + (size_t)(t + 2) * kstepB;
            const char* a3 = a2 + kstepA; const char* b3 = b2 + kstepB;
            PG8_LDB(B0, 0, 0); PG8_LDB(B1, 0, 1); PG8_SCHED; PG8_LDA(At, 0, 0); PG8_STAGE(PG8_SA(1, 1), a1 + hstepA, voffA);
            PG8_WAIT_V(8); PG8_WAIT_L(0); PG8_BAR; PG8_MMA(0, 0, At, B0); PG8_MMA(0, 1, At, B1); PG8_BAR; PG8_SCHED;
            PG8_LDA(At, 0, 1); PG8_STAGE(PG8_SB(0, 0), b2, voffB); PG8_STAGE(PG8_SB(0, 1), b2 + hstepB, voffB); PG8_STAGE(PG8_SA(0, 0), a2, voffA);
            PG8_WAIT_V(8); PG8_WAIT_L(0); PG8_BAR; PG8_MMA(1, 0, At, B0); PG8_MMA(1, 1, At, B1); PG8_BAR; PG8_SCHED;
            PG8_LDB(B0, 1, 0); PG8_LDB(B1, 1, 1); PG8_SCHED; PG8_LDA(At, 1, 0); PG8_STAGE(PG8_SA(0, 1), a2 + hstepA, voffA);
            PG8_WAIT_V(8); PG8_WAIT_L(0); PG8_BAR; PG8_MMA(0, 0, At, B0); PG8_MMA(0, 1, At, B1); PG8_BAR; PG8_SCHED;
            PG8_LDA(At, 1, 1); PG8_STAGE(PG8_SB(1, 0), b3, voffB); PG8_STAGE(PG8_SB(1, 1), b3 + hstepB, voffB); PG8_STAGE(PG8_SA(1, 0), a3, voffA);
            PG8_WAIT_V(8); PG8_WAIT_L(0); PG8_BAR; PG8_MMA(1, 0, At, B0); PG8_MMA(1, 1, At, B1); PG8_BAR; PG8_SCHED;
        }
        if (wr == 0) PG8_BAR;
        { int l2; asm volatile("v_mbcnt_lo_u32_b32 %0, -1, 0\n\tv_mbcnt_hi_u32_b32 %0, -1, %0" : "=v"(l2)); E(acc, cur, wr, wc, l2 & 15, l2 >> 4); }
        if (!has_next) break;
#pragma unroll
        for (int a = 0; a < 2; ++a)
#pragma unroll
            for (int b = 0; b < 2; ++b)
#pragma unroll
                for (int m = 0; m < 4; ++m)
#pragma unroll
                    for (int n = 0; n < 2; ++n) acc[a][b][m][n] = (f32x4){0.f, 0.f, 0.f, 0.f};
        cur = nxt; cA = nA; cB = nB; ++ui;
        if (wr == 1) PG8_BAR;
    }
    PG8_WAIT_V(0);
    PG8_BAR;
#undef PG8_SA
#undef PG8_SB
#undef PG8_STAGE
#undef PG8_LDA
#undef PG8_LDB
#undef PG8_MMA
#undef PG8_WAIT_V
#undef PG8_WAIT_L
#undef PG8_BAR
#undef PG8_SCHED
}

typedef const f32x4 (&AccT)[2][2][4][2];

struct EpiF32 {
    static constexpr bool PERM = false;
    float* C; int ldc;
    __device__ __forceinline__ void operator()(AccT acc, const Unit& u, int wr, int wc, int fr, int fq) const {
        const int row0 = u.pm * BM + wr * 64 + fr, col0 = u.pn * BM + wc * 32 + 4 * fq;
#pragma unroll
        for (int ai = 0; ai < 2; ++ai)
#pragma unroll
            for (int m = 0; m < 4; ++m) { float* rowp = C + (size_t)(row0 + ai * HALF + m * 16) * ldc + col0;
#pragma unroll
                for (int bj = 0; bj < 2; ++bj)
#pragma unroll
                    for (int n = 0; n < 2; ++n) *(f32x4*)(rowp + bj * HALF + n * 16) = acc[ai][bj][m][n]; }
    }
};
struct EpiResid {
    static constexpr bool PERM = false;
    const float* Xin; float* Xout; const float* gate; float pscale;
    __device__ __forceinline__ void operator()(AccT acc, const Unit& u, int wr, int wc, int fr, int fq) const {
        const int row0 = u.pm * BM + wr * 64 + fr, col0 = u.pn * BM + wc * 32 + 4 * fq;
        const float* gp = gate + (size_t)((u.pm * BM) >> 12) * 3072 + col0;
        f32x4 gv[2][2];
#pragma unroll
        for (int bj = 0; bj < 2; ++bj)
#pragma unroll
            for (int n = 0; n < 2; ++n) gv[bj][n] = *(const f32x4*)(gp + bj * HALF + n * 16);
        f32x4 xv[2][4];
#pragma unroll
        for (int q = 0; q < 4; ++q) xv[0][q] = ldg16f(Xin + (size_t)row0 * D + col0 + (q >> 1) * HALF + (q & 1) * 16);
#pragma unroll
        for (int i = 0; i < 8; ++i) { const int ai = i >> 2, m = i & 3;
            if (i + 1 < 8) { const size_t rn = (size_t)(row0 + ((i + 1) >> 2) * HALF + ((i + 1) & 3) * 16) * D + col0;
#pragma unroll
                for (int q = 0; q < 4; ++q) xv[(i + 1) & 1][q] = ldg16f(Xin + rn + (q >> 1) * HALF + (q & 1) * 16); }
            const size_t ro = (size_t)(row0 + ai * HALF + m * 16) * D + col0;
#pragma unroll
            for (int q = 0; q < 4; ++q) { const int bj = q >> 1, n = q & 1;
                *(GAS f32x4*)(Xout + ro + bj * HALF + n * 16) = xv[i & 1][q] + (gv[bj][n] * pscale) * acc[ai][bj][m][n]; }
            asm volatile("" ::: "memory"); }
    }
};
struct EpiSwiglu {
    static constexpr bool PERM = true;
    bf16_t* O; int ldo;
    __device__ __forceinline__ void operator()(AccT acc, const Unit& u, int wr, int wc, int fr, int fq) const {
        const int row0 = u.pm * BM + wr * 64 + fr, col0 = u.pn * HALF + wc * 32 + 8 * fq;
#pragma unroll
        for (int ai = 0; ai < 2; ++ai)
#pragma unroll
            for (int m = 0; m < 4; ++m) { bf16_t* rowp = O + (size_t)(row0 + ai * HALF + m * 16) * ldo + col0;
                const f32x4 a0 = acc[ai][0][m][0], a1 = acc[ai][0][m][1], b0 = acc[ai][1][m][0], b1 = acc[ai][1][m][1];
                u32x4 w;
                w.x = cvtpk(silu_f(a0[0]) * b0[0], silu_f(a0[1]) * b0[1]); w.y = cvtpk(silu_f(a0[2]) * b0[2], silu_f(a0[3]) * b0[3]);
                w.z = cvtpk(silu_f(a1[0]) * b1[0], silu_f(a1[1]) * b1[1]); w.w = cvtpk(silu_f(a1[2]) * b1[2], silu_f(a1[3]) * b1[3]);
                *(u32x4*)rowp = w; asm volatile("" ::: "memory"); }
    }
};
__device__ __forceinline__ void rope8(f32x4& v0, f32x4& v1, const float* rc, const float* rs, int pos, int j0) {
    const f32x4 c = *(const f32x4*)(rc + pos * 8 + j0), s = *(const f32x4*)(rs + pos * 8 + j0);
    f32x4 o0, o1;
    o0[0] = v0[0] * c[0] - v0[1] * s[0]; o0[1] = v0[1] * c[0] + v0[0] * s[0];
    o0[2] = v0[2] * c[1] - v0[3] * s[1]; o0[3] = v0[3] * c[1] + v0[2] * s[1];
    o1[0] = v1[0] * c[2] - v1[1] * s[2]; o1[1] = v1[1] * c[2] + v1[0] * s[2];
    o1[2] = v1[2] * c[3] - v1[3] * s[3]; o1[3] = v1[3] * c[3] + v1[2] * s[3];
    v0 = o0; v1 = o1;
}
__device__ __forceinline__ void rope8cs(f32x4& v0, f32x4& v1, const f32x4 c, const f32x4 s) {
    f32x4 o0, o1;
    o0[0] = v0[0] * c[0] - v0[1] * s[0]; o0[1] = v0[1] * c[0] + v0[0] * s[0];
    o0[2] = v0[2] * c[1] - v0[3] * s[1]; o0[3] = v0[3] * c[1] + v0[2] * s[1];
    o1[0] = v1[0] * c[2] - v1[1] * s[2]; o1[1] = v1[1] * c[2] + v1[0] * s[2];
    o1[2] = v1[2] * c[3] - v1[3] * s[3]; o1[3] = v1[3] * c[3] + v1[2] * s[3];
    v0 = o0; v1 = o1;
}
template <bool ISQ> struct EpiQ {
    static constexpr bool PERM = true;
    bf16_t* O; const float* rc; const float* rs;
    __device__ __forceinline__ void operator()(AccT acc, const Unit& u, int wr, int wc, int fr, int fq) const {
        const int row0 = u.pm * BM + wr * 64 + fr;
        constexpr int ld = ISQ ? 2560 : 512; constexpr float sc = ISQ ? 0.125f : 1.f;
#pragma unroll
        for (int bj = 0; bj < 2; ++bj) {
            const int cc = u.pn * BM + bj * HALF + wc * 32 + 8 * fq;
            const int blk = ISQ ? (cc % 160) : (cc & 63);
            const bool rope = blk < 16;
#pragma unroll
            for (int ai = 0; ai < 2; ++ai) {
                f32x4 cv[4], sv[4];
                if (rope) {
#pragma unroll
                    for (int m = 0; m < 4; ++m) { const int pos = (row0 + ai * HALF + m * 16) & (S - 1); cv[m] = ldg16f(rc + pos * 8 + (blk >> 1)); sv[m] = ldg16f(rs + pos * 8 + (blk >> 1)); } }
#pragma unroll
                for (int m = 0; m < 4; ++m) { const int r = row0 + ai * HALF + m * 16;
                    f32x4 v0 = acc[ai][bj][m][0], v1 = acc[ai][bj][m][1];
                    if (rope) rope8cs(v0, v1, cv[m], sv[m]);
                    v0 = v0 * sc; v1 = v1 * sc;
                    u32x4 w; w.x = cvtpk(v0[0], v0[1]); w.y = cvtpk(v0[2], v0[3]); w.z = cvtpk(v1[0], v1[1]); w.w = cvtpk(v1[2], v1[3]);
                    *(u32x4*)(O + (size_t)r * ld + cc) = w; }
                asm volatile("" ::: "memory"); }
        }
    }
};
struct EpiNsaIn {
    static constexpr bool PERM = true;
    bf16_t* P1; float* GATES; const float* rc; const float* rs;
    __device__ __forceinline__ void operator()(AccT acc, const Unit& u, int wr, int wc, int fr, int fq) const {
        const int row0 = u.pm * BM + wr * 64 + fr;
#pragma unroll
        for (int bj = 0; bj < 2; ++bj) {
            const int gc = u.pn * BM + bj * HALF + wc * 32 + 8 * fq;
            if (gc >= 2560) {
                if (gc < NSA_IN) {
#pragma unroll
                    for (int ai = 0; ai < 2; ++ai)
#pragma unroll
                        for (int m = 0; m < 4; ++m) { const int r = row0 + ai * HALF + m * 16; const f32x4 v0 = acc[ai][bj][m][0], v1 = acc[ai][bj][m][1];
                            float* gp = GATES + (size_t)r * 48 + (gc - 2560);
                            *(f32x4*)gp = (f32x4){sigmoid_f(v0[0]), sigmoid_f(v0[1]), sigmoid_f(v0[2]), sigmoid_f(v0[3])};
                            *(f32x4*)(gp + 4) = (f32x4){sigmoid_f(v1[0]), sigmoid_f(v1[1]), sigmoid_f(v1[2]), sigmoid_f(v1[3])}; asm volatile("" ::: "memory"); }
                }
                continue;
            }
            const bool isq = gc < 1024; const int reg = (gc - 1024) >> 8;
            const bool rope = ((gc & 63) < 16) && (isq || ((reg & 1) == 0));
            const float sc = isq ? C2 : 1.f;
#pragma unroll
            for (int ai = 0; ai < 2; ++ai) {
                f32x4 cv[4], sv[4];
                if (rope) {
#pragma unroll
                    for (int m = 0; m < 4; ++m) { const int pos = (row0 + ai * HALF + m * 16) & (S - 1); cv[m] = ldg16f(rc + pos * 8 + ((gc & 63) >> 1)); sv[m] = ldg16f(rs + pos * 8 + ((gc & 63) >> 1)); } }
#pragma unroll
                for (int m = 0; m < 4; ++m) { const int r = row0 + ai * HALF + m * 16;
                    f32x4 v0 = acc[ai][bj][m][0], v1 = acc[ai][bj][m][1];
                    if (rope) rope8cs(v0, v1, cv[m], sv[m]);
                    v0 = v0 * sc; v1 = v1 * sc;
                    u32x4 w; w.x = cvtpk(v0[0], v0[1]); w.y = cvtpk(v0[2], v0[3]); w.z = cvtpk(v1[0], v1[1]); w.w = cvtpk(v1[2], v1[3]);
                    *(u32x4*)(P1 + (size_t)r * FF + gc) = w; }
                asm volatile("" ::: "memory"); }
        }
    }
};
struct EpiNsaGate {
    static constexpr bool PERM = true;
    float* GATES;
    __device__ __forceinline__ void operator()(AccT acc, const Unit& u, int wr, int wc, int fr, int fq) const {
        const int row0 = u.pm * BM + wr * 64 + fr; const int gc = 2560 + wc * 32 + 8 * fq;
        if (gc < NSA_IN) {
#pragma unroll
            for (int ai = 0; ai < 2; ++ai)
#pragma unroll
                for (int m = 0; m < 4; ++m) { const int r = row0 + ai * HALF + m * 16; const f32x4 v0 = acc[ai][0][m][0], v1 = acc[ai][0][m][1];
                    float* gp = GATES + (size_t)r * 48 + (gc - 2560);
                    *(f32x4*)gp = (f32x4){sigmoid_f(v0[0]), sigmoid_f(v0[1]), sigmoid_f(v0[2]), sigmoid_f(v0[3])};
                    *(f32x4*)(gp + 4) = (f32x4){sigmoid_f(v1[0]), sigmoid_f(v1[1]), sigmoid_f(v1[2]), sigmoid_f(v1[3])}; asm volatile("" ::: "memory"); }
        }
    }
};
struct EpiCmpH {
    static constexpr bool PERM = true;
    bf16_t* O; const float* bias; int coloff;
    __device__ __forceinline__ void operator()(AccT acc, const Unit& u, int wr, int wc, int fr, int fq) const {
        const int row0 = u.pm * BM + wr * 64 + fr;
#pragma unroll
        for (int bj = 0; bj < 2; ++bj) { const int c = bj * HALF + wc * 32 + 8 * fq;
            const f32x4 bv0 = *(const f32x4*)(bias + c), bv1 = *(const f32x4*)(bias + c + 4);
#pragma unroll
            for (int ai = 0; ai < 2; ++ai)
#pragma unroll
                for (int m = 0; m < 4; ++m) { const int r = row0 + ai * HALF + m * 16;
                    const f32x4 v0 = acc[ai][bj][m][0] + bv0, v1 = acc[ai][bj][m][1] + bv1;
                    u32x4 w; w.x = cvtpk(silu_f(v0[0]), silu_f(v0[1])); w.y = cvtpk(silu_f(v0[2]), silu_f(v0[3])); w.z = cvtpk(silu_f(v1[0]), silu_f(v1[1])); w.w = cvtpk(silu_f(v1[2]), silu_f(v1[3]));
                    *(u32x4*)(O + (size_t)r * 512 + coloff + c) = w; asm volatile("" ::: "memory"); } }
    }
};
struct EpiCmpO {
    static constexpr bool PERM = true;
    bf16_t* O;
    __device__ __forceinline__ void operator()(AccT acc, const Unit& u, int wr, int wc, int fr, int fq) const {
        const int row0 = u.pm * BM + wr * 64 + fr; const int c = wc * 32 + 8 * fq;
#pragma unroll
        for (int ai = 0; ai < 2; ++ai)
#pragma unroll
            for (int m = 0; m < 4; ++m) { const int r = row0 + ai * HALF + m * 16;
                const f32x4 v0 = acc[ai][0][m][0], v1 = acc[ai][0][m][1];
                u32x4 w; w.x = cvtpk(v0[0], v0[1]); w.y = cvtpk(v0[2], v0[3]); w.z = cvtpk(v1[0], v1[1]); w.w = cvtpk(v1[2], v1[3]);
                *(u32x4*)(O + (size_t)r * 128 + c) = w; }
    }
};
struct EpiMoeDown {
    static constexpr bool PERM = false;
    float* X; const float* gate; const int* slot_tok; const float* slot_gate; int row0s; float pscale;
    __device__ __forceinline__ void operator()(AccT acc, const Unit& u, int wr, int wc, int fr, int fq) const {
        const int row0 = u.pm * BM + wr * 64 + fr, col0 = u.pn * BM + wc * 32 + 4 * fq;
        int tk[8]; float gg[8];
#pragma unroll
        for (int i = 0; i < 8; ++i) { const int sr = row0s + row0 + (i >> 2) * HALF + (i & 3) * 16; tk[i] = slot_tok[sr]; gg[i] = slot_gate[sr] * pscale; }
        f32x4 xv[2][4], gv[2][4];
        { const int tc = tk[0] > 0 ? tk[0] : 0; const float* xp = X + (size_t)tc * D + col0; const float* gp = gate + (size_t)(tc >> 12) * 3072 + col0;
#pragma unroll
          for (int q = 0; q < 4; ++q) { xv[0][q] = ldg16f(xp + (q >> 1) * HALF + (q & 1) * 16); gv[0][q] = ldg16f(gp + (q >> 1) * HALF + (q & 1) * 16); } }
#pragma unroll
        for (int i = 0; i < 8; ++i) { const int ai = i >> 2, m = i & 3;
            if (i + 1 < 8) { const int tc = tk[i + 1] > 0 ? tk[i + 1] : 0; const float* xp = X + (size_t)tc * D + col0; const float* gp = gate + (size_t)(tc >> 12) * 3072 + col0;
#pragma unroll
                for (int q = 0; q < 4; ++q) { xv[(i + 1) & 1][q] = ldg16f(xp + (q >> 1) * HALF + (q & 1) * 16); gv[(i + 1) & 1][q] = ldg16f(gp + (q >> 1) * HALF + (q & 1) * 16); } }
            if (tk[i] >= 0) { float* xo = X + (size_t)tk[i] * D + col0;
#pragma unroll
                for (int q = 0; q < 4; ++q) { const int bj = q >> 1, n = q & 1;
                    *(GAS f32x4*)(xo + bj * HALF + n * 16) = xv[i & 1][q] + (gv[i & 1][q] * gg[i]) * acc[ai][bj][m][n]; } }
            asm volatile("" ::: "memory"); }
    }
};
}

struct Args { const float* in[29]; float* out; unsigned char* ws; int ph_lo, ph_hi; };
enum { I_X = 0, I_C, I_NORM_MIX, I_NORM_FFN, I_ADA_W, I_ADA_B, I_FINAL_NORM, I_DSA_W_IN, I_DSA_G_Q, I_DSA_W_UQ, I_DSA_G_KV, I_DSA_W_UK, I_DSA_W_UV, I_DSA_W_IQ, I_DSA_W_O,
       I_FFN_W1, I_FFN_W3, I_FFN_W2, I_NSA_W_IN, I_NSA_CMP_PE, I_NSA_CMP_K1, I_NSA_CMP_K2, I_NSA_CMP_V1, I_NSA_CMP_V2, I_NSA_W_O, I_MOE_ROUTER, I_MOE_W1, I_MOE_W3, I_MOE_W2 };

template <class F>
__device__ __forceinline__ void conv_one(const F& f, int N, int K, bf16_t* WT, LAS float* scr, int it, int lane) {
    const int nblk = N / 32; const int kb = it / nblk, nb = it % nblk, k0 = 64 * kb, n0 = 32 * nb;
    float tv[32];
#pragma unroll
    for (int i = 0; i < 32; ++i) tv[i] = f(k0 + 2 * i + (lane >> 5), n0 + (lane & 31));
#pragma unroll
    for (int i = 0; i < 32; ++i) { const int kk = 2 * i + (lane >> 5); scr[kk * 33 + (lane & 31)] = tv[i]; }
    asm volatile("s_waitcnt lgkmcnt(0)" ::: "memory");
    const int c = lane & 7;
#pragma unroll
    for (int j = 0; j < 4; ++j) { const int n = (lane >> 3) + 8 * j; const LAS float* s = scr + (8 * c) * 33 + n;
        u32x4 o; o.x = cvtpk(s[0 * 33], s[1 * 33]); o.y = cvtpk(s[2 * 33], s[3 * 33]); o.z = cvtpk(s[4 * 33], s[5 * 33]); o.w = cvtpk(s[6 * 33], s[7 * 33]);
        *(u32x4*)(WT + (size_t)(n0 + n) * K + k0 + 8 * c) = o; }
    asm volatile("s_waitcnt lgkmcnt(0)" ::: "memory");
}
template <class F>
__device__ __forceinline__ void conv_items(const F& f, int N, int K, bf16_t* WT, LAS float* scr, int gw, int NGW, int lane) {
    const int nitems = (N / 32) * (K / 64);
    for (int it = gw; it < nitems; it += NGW) conv_one(f, N, K, WT, scr, it, lane);
}
template <class F>
__device__ __forceinline__ void conv_range(const F& f, int N, int K, bf16_t* WT, LAS float* scr, int it0, int it1, int gw, int NGW, int lane) {
    for (int it = it0 + gw; it < it1; it += NGW) conv_one(f, N, K, WT, scr, it, lane);
}
struct FPlain { const float* W; int ldw; __device__ __forceinline__ float operator()(int k, int n) const { return W[(size_t)k * ldw + n]; } };
struct FIn0 { const float* W; __device__ __forceinline__ float operator()(int k, int n) const { return n < DSA_IN ? W[(size_t)k * DSA_IN + n] : 0.f; } };
struct F13 { const float* W1; const float* W3; int ff;
    __device__ __forceinline__ float operator()(int k, int n) const { const int t = n >> 8, bj = (n >> 7) & 1, j = n & 127;
        const long long delta = (const char*)W3 - (const char*)W1;
        const float* w = (const float*)((const char*)W1 + (long long)bj * delta); return w[(size_t)k * ff + t * 128 + j]; } };
struct FNin { const float* W;
    __device__ __forceinline__ float operator()(int k, int n) const {
        if (n >= NSA_IN) return 0.f;
        int src = n;
        if (n < 2560) { const bool isq = n < 1024; const int reg = (n - 1024) >> 8; const int j = n & 63;
            if (j < 16 && (isq || ((reg & 1) == 0))) src = (n & ~63) + rp16(j); }
        return W[(size_t)k * NSA_IN + src]; } };
struct FK1 { const float* W;
    __device__ __forceinline__ float operator()(int k, int n) const { const int d = k & 63; const int ks = d < 16 ? (k & ~63) + rp16(d) : k; return W[(size_t)ks * 256 + n]; } };
struct FK2V2 { const float* K2; const float* V2;
    __device__ __forceinline__ float operator()(int k, int n) const {
        if (n < 64) return k < 256 ? K2[(size_t)k * 64 + n] : 0.f;
        if (n < 128) return k >= 256 ? V2[(size_t)(k - 256) * 64 + (n - 64)] : 0.f;
        return 0.f; } };
struct FQ { const float* Wuq; const float* Wiq; const float* TMPQ;
    __device__ __forceinline__ float operator()(int k, int n) const {
        if (n < 2560) { const int h = n / 160, j = n - h * 160;
            if (j < 16) return Wuq[(size_t)k * 1024 + h * 64 + rp16(j)];
            if (j < 144) return TMPQ[(size_t)k * 2048 + h * 128 + (j - 16)];
            return 0.f; }
        const int m = n - 2560, j = m & 63; const int src = (m & ~63) + (j < 16 ? rp16(j) : j);
        return Wiq[(size_t)k * 512 + src]; } };

template <int NBV>
__device__ __forceinline__ void gemv_item(const LAS float* act, const float* W, int ldw, int K, int n0, const float* bias, float* out, int out_stride, LAS float* red, int wave, int lane) {
    const int kc = K / 8, k0 = wave * kc;
    float acc[NBV];
#pragma unroll
    for (int b = 0; b < NBV; ++b) acc[b] = 0.f;
    float wa[16], wb[16];
#pragma unroll
    for (int i = 0; i < 16; ++i) wa[i] = *(const GAS float*)(W + (size_t)(k0 + i) * ldw + n0 + lane);
    for (int k = k0; k < k0 + kc; k += 32) {
#pragma unroll
        for (int i = 0; i < 16; ++i) wb[i] = *(const GAS float*)(W + (size_t)(k + 16 + i) * ldw + n0 + lane);
#pragma unroll
        for (int b = 0; b < NBV; ++b) {
#pragma unroll
            for (int i4 = 0; i4 < 4; ++i4) { const f32x4 a = *(const LAS f32x4*)(act + b * K + k + 4 * i4);
                acc[b] += a[0] * wa[4 * i4] + a[1] * wa[4 * i4 + 1] + a[2] * wa[4 * i4 + 2] + a[3] * wa[4 * i4 + 3]; } }
        { const int kn = (k + 32 < k0 + kc) ? k + 32 : k0;
#pragma unroll
          for (int i = 0; i < 16; ++i) wa[i] = *(const GAS float*)(W + (size_t)(kn + i) * ldw + n0 + lane); }
#pragma unroll
        for (int b = 0; b < NBV; ++b) {
#pragma unroll
            for (int i4 = 0; i4 < 4; ++i4) { const f32x4 a = *(const LAS f32x4*)(act + b * K + k + 16 + 4 * i4);
                acc[b] += a[0] * wb[4 * i4] + a[1] * wb[4 * i4 + 1] + a[2] * wb[4 * i4 + 2] + a[3] * wb[4 * i4 + 3]; } }
    }
#pragma unroll
    for (int b = 0; b < NBV; ++b) red[(wave * NBV + b) * 64 + lane] = acc[b];
    __syncthreads();
    for (int b = wave; b < NBV; b += 8) { float s = 0.f;
#pragma unroll
        for (int w = 0; w < 8; ++w) s += red[(w * NBV + b) * 64 + lane];
        out[(size_t)b * out_stride + n0 + lane] = s + (bias ? bias[n0 + lane] : 0.f); }
    __syncthreads();
}

__device__ __forceinline__ void mod_row(const float* xrow, const float* g, const float* modb, bf16_t* orow, int lane) {
    f32x4 v[4]; float ss = 0.f;
#pragma unroll
    for (int j = 0; j < 4; ++j) { v[j] = *(const f32x4*)(xrow + 4 * lane + 256 * j); ss += (v[j][0] * v[j][0] + v[j][1] * v[j][1]) + (v[j][2] * v[j][2] + v[j][3] * v[j][3]); }
    const float r = 1.f / sqrtf(wave_sum(ss) * (1.f / D) + EPS);
#pragma unroll
    for (int j = 0; j < 4; ++j) { const int c = 4 * lane + 256 * j;
        const f32x4 gv = *(const f32x4*)(g + c), sh = *(const f32x4*)(modb + c), sc = *(const f32x4*)(modb + D + c);
        const f32x4 y = (v[j] * r) * gv * (sc + 1.f) + sh;
        u32x2 o; o.x = cvtpk(y[0], y[1]); o.y = cvtpk(y[2], y[3]);
        *(u32x2*)(orow + c) = o; }
}
__device__ __forceinline__ void mod_rows(const float* X, const float* g, const float* mod, bf16_t* H, int gw, int NGW, int lane) {
    for (int m = gw; m < T; m += 2 * NGW) {
        const int m2 = m + NGW;
        f32x4 va[4], vb[4]; float sa = 0.f, sb = 0.f;
#pragma unroll
        for (int j = 0; j < 4; ++j) va[j] = ldg16f(X + (size_t)m * D + (8 * lane + 4 * (j & 1) + 512 * (j >> 1)));
        if (m2 < T) {
#pragma unroll
            for (int j = 0; j < 4; ++j) vb[j] = ldg16f(X + (size_t)m2 * D + (8 * lane + 4 * (j & 1) + 512 * (j >> 1))); }
#pragma unroll
        for (int j = 0; j < 4; ++j) sa += (va[j][0] * va[j][0] + va[j][1] * va[j][1]) + (va[j][2] * va[j][2] + va[j][3] * va[j][3]);
        const float ra = 1.f / sqrtf(wave_sum(sa) * (1.f / D) + EPS);
        { const float* modb = mod + (size_t)(m >> 12) * 3072;
#pragma unroll
          for (int jj = 0; jj < 2; ++jj) { u32x4 o;
#pragma unroll
            for (int q = 0; q < 2; ++q) { const int j = 2 * jj + q; const int c = (8 * lane + 4 * (j & 1) + 512 * (j >> 1));
                const f32x4 gv = *(const f32x4*)(g + c), sh = *(const f32x4*)(modb + c), sc = *(const f32x4*)(modb + D + c);
                const f32x4 y = (va[j] * ra) * gv * (sc + 1.f) + sh;
                if (q == 0) { o.x = cvtpk(y[0], y[1]); o.y = cvtpk(y[2], y[3]); } else { o.z = cvtpk(y[0], y[1]); o.w = cvtpk(y[2], y[3]); } }
            stg16(H + (size_t)m * D + 8 * lane + 512 * jj, o); } }
        if (m2 < T) {
#pragma unroll
            for (int j = 0; j < 4; ++j) sb += (vb[j][0] * vb[j][0] + vb[j][1] * vb[j][1]) + (vb[j][2] * vb[j][2] + vb[j][3] * vb[j][3]);
            const float rb = 1.f / sqrtf(wave_sum(sb) * (1.f / D) + EPS);
            const float* modb = mod + (size_t)(m2 >> 12) * 3072;
#pragma unroll
            for (int jj = 0; jj < 2; ++jj) { u32x4 o;
#pragma unroll
                for (int q = 0; q < 2; ++q) { const int j = 2 * jj + q; const int c = (8 * lane + 4 * (j & 1) + 512 * (j >> 1));
                    const f32x4 gv = *(const f32x4*)(g + c), sh = *(const f32x4*)(modb + c), sc = *(const f32x4*)(modb + D + c);
                    const f32x4 y = (vb[j] * rb) * gv * (sc + 1.f) + sh;
                    if (q == 0) { o.x = cvtpk(y[0], y[1]); o.y = cvtpk(y[2], y[3]); } else { o.z = cvtpk(y[0], y[1]); o.w = cvtpk(y[2], y[3]); } }
                stg16(H + (size_t)m2 * D + 8 * lane + 512 * jj, o); } }
    }
}
__device__ __forceinline__ void dsa_post_rows(const float* P0, const float* gq, const float* gkv, const float* rc, const float* rs,
                                              bf16_t* QLN, bf16_t* KCAT, bf16_t* IK, float* IW, int gw, int NGW, int lane) {
    f32x4 an, bn;
    { const int m0 = gw < T ? gw : T - 1; an = ldg16f(P0 + (size_t)m0 * 512 + 4 * lane); bn = ldg16f(P0 + (size_t)m0 * 512 + 256 + 4 * lane); }
    for (int m = gw; m < T; m += NGW) {
        const int pos = m & (S - 1);
        const f32x4 a = an, b = bn;
        { const int mn = (m + NGW < T) ? m + NGW : m; an = ldg16f(P0 + (size_t)mn * 512 + 4 * lane); bn = ldg16f(P0 + (size_t)mn * 512 + 256 + 4 * lane); }
        const float ssq = wave_sum((a[0] * a[0] + a[1] * a[1]) + (a[2] * a[2] + a[3] * a[3]));
        const float sb = (b[0] * b[0] + b[1] * b[1]) + (b[2] * b[2] + b[3] * b[3]);
        const float sskv = wave_sum(lane < 32 ? sb : 0.f);
        const float rq = 1.f / sqrtf(ssq * (1.f / 256.f) + EPS), rkv = 1.f / sqrtf(sskv * (1.f / 128.f) + EPS);
        { const f32x4 gv = *(const f32x4*)(gq + 4 * lane); const f32x4 y = a * rq * gv; u32x2 o; o.x = cvtpk(y[0], y[1]); o.y = cvtpk(y[2], y[3]); *(u32x2*)(QLN + (size_t)m * 256 + 4 * lane) = o; }
        f32x4 p;
#pragma unroll
        for (int e = 0; e < 4; ++e) { const float be = b[e]; p[e] = __int_as_float(__builtin_amdgcn_update_dpp(0, __float_as_int(be), 0x4E, 0xF, 0xF, true)); }
        if (lane < 32) { const f32x4 gv = *(const f32x4*)(gkv + 4 * lane); const f32x4 y = b * rkv * gv; u32x2 o; o.x = cvtpk(y[0], y[1]); o.y = cvtpk(y[2], y[3]);
            *(u32x2*)(KCAT + (size_t)m * 160 + 16 + 4 * lane) = o; }
        else if (lane == 32 || lane == 33 || lane == 36 || lane == 37) {
            const int j0 = 4 * (lane & 1);
            const f32x4 c = *(const f32x4*)(rc + pos * 8 + j0), s = *(const f32x4*)(rs + pos * 8 + j0);
            u32x4 o;
            o.x = cvtpk(b[0] * c[0] - p[0] * s[0], p[0] * c[0] + b[0] * s[0]); o.y = cvtpk(b[1] * c[1] - p[1] * s[1], p[1] * c[1] + b[1] * s[1]);
            o.z = cvtpk(b[2] * c[2] - p[2] * s[2], p[2] * c[2] + b[2] * s[2]); o.w = cvtpk(b[3] * c[3] - p[3] * s[3], p[3] * c[3] + b[3] * s[3]);
            bf16_t* dst = (lane < 36) ? KCAT + (size_t)m * 160 + 8 * (lane & 1) : IK + (size_t)m * 64 + 8 * (lane & 1);
            *(u32x4*)dst = o; }
        else if (lane >= 40 && lane < 52) { u32x2 o; o.x = cvtpk(b[0], b[1]); o.y = cvtpk(b[2], b[3]); *(u32x2*)(IK + (size_t)m * 64 + 16 + 4 * (lane - 40)) = o; }
        else if (lane == 52 || lane == 53) { const float sc = 0.35355339059327379f * 0.125f; *(f32x4*)(IW + (size_t)m * 8 + 4 * (lane - 52)) = b * sc; }
        else if (lane == 54 || lane == 55) { *(u32x4*)(KCAT + (size_t)m * 160 + 144 + 8 * (lane - 54)) = (u32x4){0u, 0u, 0u, 0u}; }
    }
}

constexpr int DSA_SEL_OFF = 131072, DSA_HIST_OFF = 135168;
static_assert(DSA_HIST_OFF + 8 * 1024 <= LDS_MISC, "DSA LDS map");
__device__ __forceinline__ s16x4 lds_tr16(const LAS unsigned char* p) { return __builtin_bit_cast(s16x4, __builtin_amdgcn_ds_read_tr16_b64_v4i16((LAS v4i16_t*)p)); }
__device__ __forceinline__ int mbcnt64(unsigned long long m) { return (int)__builtin_amdgcn_mbcnt_hi((unsigned)(m >> 32), __builtin_amdgcn_mbcnt_lo((unsigned)m, 0u)); }

__device__ __forceinline__ void dsa_core(const bf16_t* IQ, const bf16_t* IK, const float* IW, const bf16_t* QCAT, const bf16_t* KCAT, bf16_t* OLAT,
                                         LAS unsigned char* lds, int bid, int G, int wave, int lane0) {
#define DSA_LV int lane_ = lane0; asm volatile("" : "+v"(lane_)); const int lane = lane_;
    LAS float* scores = (LAS float*)lds;
    for (int u = bid; u < 4096; u += G) {
        const int b = u & 7, tr = u >> 3, ii = tr >> 5, ss = tr & 31;
        const int tile = (ii & 1) ? (ii * 32 + 31 - ss) : (ii * 32 + ss);
        const int t0 = tile * 8; const size_t tokbase = (size_t)b * S + t0;
        for (int repa = 0; repa < PROBE_REP_A; ++repa)
        {   DSA_LV
            const int r = lane & 31, h = lane >> 5; const int g_ = r >> 3, hi_ = (r >> 2) & 1, jp = r & 3;
            bf16x8 af[2][4]; f32x4 wv[2][4];
#pragma unroll
            for (int rb = 0; rb < 2; ++rb) { const int q = 4 * rb + 2 * hi_ + (g_ >> 1), head = 4 * (g_ & 1) + jp;
#pragma unroll
                for (int ks = 0; ks < 4; ++ks) af[rb][ks] = ldg16h(IQ + (tokbase + q) * 512 + head * 64 + 16 * ks + 8 * h);
#pragma unroll
                for (int g = 0; g < 4; ++g) wv[rb][g] = ldg16f(IW + (tokbase + 4 * rb + 2 * h + (g >> 1)) * 8 + 4 * (g & 1)); }
            const int nk32 = (t0 + 8 + 31) >> 5;
            const bf16_t* ikp = IK + ((size_t)b * S + r) * 64 + 8 * h;
            bf16x8 bq[4][4];
#define DSA_LDB(slot, cc) do { const int cl_ = (cc) < nk32 ? (cc) : nk32 - 1; _Pragma("unroll") for (int ks_ = 0; ks_ < 4; ++ks_) bq[slot][ks_] = ldg16h(ikp + (size_t)cl_ * 32 * 64 + 16 * ks_); } while (0)
            DSA_LDB(0, wave); DSA_LDB(1, wave + 8); DSA_LDB(2, wave + 16);
            for (int c = wave; c < nk32; c += 32) {
#pragma unroll
                for (int uu = 0; uu < 4; ++uu) {
                    const int cc = c + 8 * uu;
                    DSA_LDB((uu + 3) & 3, cc + 24);
                    if (cc < nk32) {
                        const int key = 32 * cc + r;
#pragma unroll
                        for (int rb = 0; rb < 2; ++rb) {
                            f32x16 acc = {};
#pragma unroll
                            for (int ks = 0; ks < 4; ++ks) acc = __builtin_amdgcn_mfma_f32_32x32x16_bf16(af[rb][ks], bq[uu][ks], acc, 0, 0, 0);
                            float s0 = 0.f, s1 = 0.f;
#pragma unroll
                            for (int g = 0; g < 2; ++g)
#pragma unroll
                                for (int j = 0; j < 4; ++j) {
                                    const float a0_ = acc[4 * g + j], a1_ = acc[8 + 4 * g + j];
                                    const int i0 = __float_as_int(a0_), i1 = __float_as_int(a1_);
                                    s0 += __int_as_float(i0 > 0 ? i0 : 0) * wv[rb][g][j]; s1 += __int_as_float(i1 > 0 ? i1 : 0) * wv[rb][2 + g][j]; }
                            const int qa = 4 * rb + 2 * h;
                            scores[qa * 4096 + key] = s0 + 0.f; scores[(qa + 1) * 4096 + key] = s1 + 0.f;
                        }
                    }
                }
            }
#undef DSA_LDB
        }
        __syncthreads();
        const int t = t0 + wave;
        bf16x8 qf[5];
        {   DSA_LV
            const int hd = lane & 15, g4 = lane >> 4;
#pragma unroll
            for (int ks = 0; ks < 5; ++ks) qf[ks] = ldg16h(QCAT + (tokbase + wave) * 2560 + hd * 160 + 32 * ks + 8 * g4);
        }
        LAS unsigned short* sel = (LAS unsigned short*)(lds + DSA_SEL_OFF) + wave * 256;
        int nvalid;
        for (int repb = 0; repb < PROBE_REP_B; ++repb)
        {   DSA_LV
        if (t < 256) {
            for (int i = lane; i < 256; i += 64) sel[i] = (unsigned short)((i <= t) ? i : 0);
            nvalid = t + 1;
        } else {
            LAS unsigned* hist = (LAS unsigned*)(lds + DSA_HIST_OFF) + wave * 256;
            unsigned key[64];
            const int jmax = t >> 6;
#pragma unroll
            for (int jg = 0; jg < 16; ++jg) {
                if (4 * jg <= jmax) {
#pragma unroll
                    for (int jj = 0; jj < 4; ++jj) { const int j = 4 * jg + jj; const int idx = 64 * j + lane; const unsigned uu = __float_as_uint(scores[wave * 4096 + idx]);
                        const unsigned k = (uu >> 31) ? ~uu : (uu | 0x80000000u); key[j] = (idx <= t) ? k : 0u; }
                } else {
#pragma unroll
                    for (int jj = 0; jj < 4; ++jj) key[4 * jg + jj] = 0u;
                } }
            unsigned mxk = 0u;
#pragma unroll
            for (int jg = 0; jg < 16; ++jg) if (4 * jg <= jmax) {
#pragma unroll
                for (int jj = 0; jj < 4; ++jj) { const int j = 4 * jg + jj; mxk = key[j] > mxk ? key[j] : mxk; } }
            mxk = wave_max_u(mxk);
            unsigned base = mxk; int sh = 16, krem = 256;
#pragma unroll 1
            for (int it = 0; it < 12; ++it) {
                *(LAS u32x4*)(hist + 4 * lane) = (u32x4){0u, 0u, 0u, 0u};
                asm volatile("s_waitcnt lgkmcnt(0)" ::: "memory");
#pragma unroll
                for (int jg = 0; jg < 16; ++jg) if (4 * jg <= jmax) {
#pragma unroll
                    for (int jj = 0; jj < 4; ++jj) { const unsigned k = key[4 * jg + jj]; const unsigned bin = (base - k) >> sh;
                        if (bin < 256u && k != 0u) __hip_atomic_fetch_add(hist + bin, 1u, __ATOMIC_RELAXED, __HIP_MEMORY_SCOPE_WORKGROUP); } }
                asm volatile("s_waitcnt lgkmcnt(0)" ::: "memory");
                const u32x4 hv = *(const LAS u32x4*)(hist + 4 * lane);
                const int own = (int)(hv[0] + hv[1] + hv[2] + hv[3]);
                const int pre = wave_scan_incl_i(own);
                const int c0 = pre - own, c1 = c0 + (int)hv[0], c2 = c1 + (int)hv[1], c3 = c2 + (int)hv[2];
                int dsel = -1, csel = 0;
                if (c0 < krem && krem <= c0 + (int)hv[0]) { dsel = 0; csel = c0; }
                else if (c1 < krem && krem <= c1 + (int)hv[1]) { dsel = 1; csel = c1; }
                else if (c2 < krem && krem <= c2 + (int)hv[2]) { dsel = 2; csel = c2; }
                else if (c3 < krem && krem <= c3 + (int)hv[3]) { dsel = 3; csel = c3; }
                const unsigned long long mfound = __ballot(dsel >= 0);
                if (mfound == 0ull) { sh = sh + 6 > 24 ? 24 : sh + 6; continue; }
                const int src = __builtin_ctzll(mfound);
                const int bsel = __builtin_amdgcn_readlane(4 * lane + dsel, src), cbel = __builtin_amdgcn_readlane(csel, src);
                krem -= cbel; base -= ((unsigned)bsel << sh);
                if (sh == 0) break;
                {
                    const int hsel = dsel == 0 ? (int)hv[0] : dsel == 1 ? (int)hv[1] : dsel == 2 ? (int)hv[2] : (int)hv[3];
                    const int nb = __builtin_amdgcn_readlane(hsel, src);
                    if (krem == nb && base >= (1u << sh)) { base -= (1u << sh); krem = 0; break; } }
                sh = sh >= 8 ? sh - 8 : 0;
            }
            const unsigned prefix = base;
            const unsigned Tq = prefix;
            int cge = 0, ceq = 0;
#pragma unroll
            for (int jg = 0; jg < 16; ++jg) if (4 * jg <= jmax) {
#pragma unroll
                for (int jj = 0; jj < 4; ++jj) { const int j = 4 * jg + jj; cge += (key[j] >= Tq) ? 1 : 0; ceq += (key[j] == Tq) ? 1 : 0; } }
            const int toteq = wave_total_i(ceq);
            if (toteq == krem) {
                int pos = wave_scan_incl_i(cge) - cge;
#pragma unroll
                for (int jg = 0; jg < 16; ++jg) if (4 * jg <= jmax) {
#pragma unroll
                    for (int jj = 0; jj < 4; ++jj) { const int j = 4 * jg + jj; if (key[j] >= Tq) { if (pos < 256) sel[pos] = (unsigned short)(64 * j + lane); ++pos; } } }
            } else {
                const int need_eq = krem; int base = 0, eq_seen = 0;
#pragma unroll
                for (int j = 0; j < 64; ++j) if (j <= jmax) {
                    const bool gt = key[j] > Tq, eq = key[j] == Tq;
                    const unsigned long long m_eq = __ballot(eq);
                    const int rank_eq = eq_seen + mbcnt64(m_eq);
                    const bool take = gt || (eq && rank_eq < need_eq);
                    const unsigned long long m_tk = __ballot(take);
                    const int pos = base + mbcnt64(m_tk);
                    if (take && pos < 256) sel[pos] = (unsigned short)(64 * j + lane);
                    base += __builtin_popcountll(m_tk); eq_seen += __builtin_popcountll(m_eq);
                }
            }
            nvalid = 256;
        }
        }
        asm volatile("s_waitcnt lgkmcnt(0)" ::: "memory");
        for (int repc = 0; repc < PROBE_REP_C; ++repc)
        {   DSA_LV
            const int hd = lane & 15, g4 = lane >> 4;
            asm volatile("s_waitcnt vmcnt(0)" ::: "memory");
            const char* kbase = (const char*)(KCAT + (size_t)b * S * 160);
            LAS unsigned char* vb = lds + wave * 16384;
            const unsigned vb_addr = (unsigned)(uintptr_t)vb;
#define DSA_DMA(gsrc, ldsoff) do { unsigned keep_; asm volatile("s_mov_b32 %0, m0\n\ts_mov_b32 m0, %2\n\ts_nop 0\n\tglobal_load_lds_dwordx4 %1, off\n\ts_mov_b32 m0, %0" \
                : "=&s"(keep_) : "v"(gsrc), "s"((unsigned)__builtin_amdgcn_readfirstlane(vb_addr + (unsigned)(ldsoff))) : "memory"); } while (0)
#define DSA_KTILE(tl) do { const int kx_ = sel[16 * (tl) + hd]; const char* src_ = kbase + (size_t)kx_ * 320 + 16 * g4; \
                _Pragma("unroll") for (int ks_ = 0; ks_ < 5; ++ks_) DSA_DMA(src_ + 64 * ks_, ((tl) % 3) * 5120 + ks_ * 1024); } while (0)
            f32x4 o[8];
#pragma unroll
            for (int nb = 0; nb < 8; ++nb) o[nb] = (f32x4){0.f, 0.f, 0.f, 0.f};
            float mref = -1e30f, lsum = 0.f;
            const int li = lane & 15, tq = li >> 2, tp = li & 3;
            DSA_KTILE(0); DSA_KTILE(1); DSA_KTILE(2);
#pragma unroll
            for (int tl = 0; tl < 16; ++tl) {
                if (tl < 14) asm volatile("s_waitcnt vmcnt(10)" ::: "memory"); else if (tl == 14) asm volatile("s_waitcnt vmcnt(5)" ::: "memory"); else asm volatile("s_waitcnt vmcnt(0)" ::: "memory");
                const LAS unsigned char* sb = vb + (tl % 3) * 5120;
                bf16x8 kf[5];
#pragma unroll
                for (int ks = 0; ks < 5; ++ks) kf[ks] = *(const LAS bf16x8*)(sb + ks * 1024 + lane * 16);
                s16x4 vt[8];
#pragma unroll
                for (int nb = 0; nb < 8; ++nb) { const int d0 = 16 + 16 * nb;
                    vt[nb] = lds_tr16(sb + ((d0 >> 5) * 1024) + ((((d0 & 31) >> 3) + (tp >> 1)) * 256) + (4 * g4 + tq) * 16 + 8 * (tp & 1)); }
                asm volatile("s_waitcnt lgkmcnt(0)" ::: "memory");
                if (tl + 3 < 16) DSA_KTILE(tl + 3);
                f32x4 acc = {0.f, 0.f, 0.f, 0.f};
#pragma unroll
                for (int ks = 0; ks < 5; ++ks) acc = __builtin_amdgcn_mfma_f32_16x16x32_bf16(kf[ks], qf[ks], acc, 0, 0, 0);
#pragma unroll
                for (int rg = 0; rg < 4; ++rg) if (16 * tl + 4 * g4 + rg >= nvalid) acc[rg] = -INFINITY;
                const float lm = fmaxf(fmaxf(acc[0], acc[1]), fmaxf(acc[2], acc[3]));
                if (__any(lm > mref + 8.f)) {
                    float mx = fmaxf(lm, __shfl_xor(lm, 16)); mx = fmaxf(mx, __shfl_xor(mx, 32));
                    const float mn = fmaxf(mref, mx), alpha = fast_exp2((mref - mn) * LOG2E); mref = mn; lsum *= alpha;
#pragma unroll
                    for (int nb = 0; nb < 8; ++nb) o[nb] = o[nb] * alpha;
                }
                const float p0 = fast_exp2((acc[0] - mref) * LOG2E), p1 = fast_exp2((acc[1] - mref) * LOG2E), p2 = fast_exp2((acc[2] - mref) * LOG2E), p3 = fast_exp2((acc[3] - mref) * LOG2E);
                lsum += (p0 + p1) + (p2 + p3);
                u32x2 pw; pw.x = cvtpk(p0, p1); pw.y = cvtpk(p2, p3);
                const s16x4 pb = __builtin_bit_cast(s16x4, pw);
#pragma unroll
                for (int nb = 0; nb < 8; ++nb) o[nb] = __builtin_amdgcn_mfma_f32_16x16x16bf16_1k(vt[nb], pb, o[nb], 0, 0, 0);
            }
            lsum += __shfl_xor(lsum, 16); lsum += __shfl_xor(lsum, 32);
#undef DSA_DMA
#undef DSA_KTILE
#undef DSA_VCHUNK
            const float inv = 1.f / lsum;
            bf16_t* op = OLAT + (tokbase + wave) * 2048 + hd * 128 + 4 * g4;
#pragma unroll
            for (int nb = 0; nb < 8; ++nb) { u32x2 w; w.x = cvtpk(o[nb][0] * inv, o[nb][1] * inv); w.y = cvtpk(o[nb][2] * inv, o[nb][3] * inv); stg8(op + 16 * nb, w); }
        }
        __syncthreads();
    }
#undef DSA_LV
}

constexpr int NSA_TB = 16384, NSA_PCS = 65536, NSA_SELM = 132096, NSA_UM = 132608, NSA_WSF = 132672, NSA_OST = 0;
constexpr int PCS_LD = 65;
static_assert(NSA_PCS + PCS_LD * 256 * 4 <= NSA_SELM && NSA_WSF + 2048 <= DSA_SEL_OFF + 16384 && NSA_WSF + 2048 <= LDS_MISC, "NSA LDS map");
__device__ __forceinline__ int crow(int r, int hi) { return (r & 3) + 8 * (r >> 2) + 4 * hi; }

struct BrState { float m, l; f32x16 o0, o1; };

__device__ __forceinline__ void nsa_qkt(f32x16& p0, f32x16& p1, const LAS unsigned char* tb, const bf16x8 (&qr)[4], int r32, int hi) {
    const LAS unsigned char* kb = tb + hi * 1024 + r32 * 16;
    p0 = (f32x16){}; p1 = (f32x16){};
#pragma unroll
    for (int d0 = 0; d0 < 4; ++d0) {
        const bf16x8 b0 = *(const LAS bf16x8*)(kb + d0 * 2048), b1 = *(const LAS bf16x8*)(kb + d0 * 2048 + 512);
        p0 = __builtin_amdgcn_mfma_f32_32x32x16_bf16(b0, qr[d0], p0, 0, 0, 0);
        p1 = __builtin_amdgcn_mfma_f32_32x32x16_bf16(b1, qr[d0], p1, 0, 0, 0);
    }
}
__device__ __forceinline__ float half_swap_max(float v) { auto rr = __builtin_amdgcn_permlane32_swap(__float_as_uint(v), __float_as_uint(v), false, false); return fmaxf(__uint_as_float(rr[0]), __uint_as_float(rr[1])); }
__device__ __forceinline__ float half_swap_sum(float v) { auto rr = __builtin_amdgcn_permlane32_swap(__float_as_uint(v), __float_as_uint(v), false, false); return __uint_as_float(rr[0]) + __uint_as_float(rr[1]); }

__device__ __forceinline__ void nsa_update(BrState& st, f32x16& p0, f32x16& p1, const LAS unsigned char* tb, LAS float* wsf, int r32, int hi, int lane, bool active) {
    float rm = fmaxf(fmaxf(p0[0], p0[1]), fmaxf(p1[0], p1[1]));
#pragma unroll
    for (int r = 2; r < 16; r += 2) rm = fmaxf(rm, fmaxf(fmaxf(p0[r], p0[r + 1]), fmaxf(p1[r], p1[r + 1])));
    rm = half_swap_max(rm);
    if (!active) rm = -INFINITY;
    if (__any(rm > st.m + 8.f)) {
        const float mn = fmaxf(st.m, rm), alpha = fast_exp2(st.m - mn); st.m = mn; st.l *= alpha;
        if (hi == 0) wsf[r32] = alpha;
        asm volatile("s_waitcnt lgkmcnt(0)" ::: "memory");
#pragma unroll
        for (int r = 0; r < 16; ++r) { const float f = wsf[crow(r, hi)]; st.o0[r] *= f; st.o1[r] *= f; }
    }
    const float mref = active ? st.m : INFINITY;
    float sum = 0.f;
#pragma unroll
    for (int r = 0; r < 16; ++r) { p0[r] = fast_exp2(p0[r] - mref); p1[r] = fast_exp2(p1[r] - mref); sum += p0[r] + p1[r]; }
    st.l += sum;
    u32x4 pw0, pw1, pw2, pw3;
    pw0 = (u32x4){cvtpk(p0[0], p0[1]), cvtpk(p0[2], p0[3]), cvtpk(p0[4], p0[5]), cvtpk(p0[6], p0[7])};
    pw1 = (u32x4){cvtpk(p0[8], p0[9]), cvtpk(p0[10], p0[11]), cvtpk(p0[12], p0[13]), cvtpk(p0[14], p0[15])};
    pw2 = (u32x4){cvtpk(p1[0], p1[1]), cvtpk(p1[2], p1[3]), cvtpk(p1[4], p1[5]), cvtpk(p1[6], p1[7])};
    pw3 = (u32x4){cvtpk(p1[8], p1[9]), cvtpk(p1[10], p1[11]), cvtpk(p1[12], p1[13]), cvtpk(p1[14], p1[15])};
    const LAS unsigned char* vp0 = tb + 8192 + ((lane >> 4) & 1) * 32 + (lane & 3) * 8 + (4 * hi + ((lane & 15) >> 2)) * 64;
#pragma unroll
    for (int d0 = 0; d0 < 2; ++d0) {
        f32x16 o = d0 ? st.o1 : st.o0;
#pragma unroll
        for (int kg = 0; kg < 4; ++kg) {
            const s16x4 lo = lds_tr16(vp0 + d0 * 4096 + kg * 1024), hh = lds_tr16(vp0 + d0 * 4096 + kg * 1024 + 512);
            const bf16x8 vf = (bf16x8){lo[0], lo[1], lo[2], lo[3], hh[0], hh[1], hh[2], hh[3]};
            const u32x4 pw = kg == 0 ? pw0 : kg == 1 ? pw1 : kg == 2 ? pw2 : pw3;
            o = __builtin_amdgcn_mfma_f32_32x32x16_bf16(__builtin_bit_cast(bf16x8, pw), vf, o, 0, 0, 0);
        }
        if (d0) st.o1 = o; else st.o0 = o;
    }
}
__device__ __forceinline__ void nsa_finish(const BrState& st, f32x16& a0, f32x16& a1, float gate, LAS float* wsf, int r32, int hi) {
    const float lt = half_swap_sum(st.l);
    const float sc = lt > 0.f ? gate / lt : 0.f;
    if (hi == 0) wsf[32 + r32] = sc;
    asm volatile("s_waitcnt lgkmcnt(0)" ::: "memory");
#pragma unroll
    for (int r = 0; r < 16; ++r) { const float f = wsf[32 + crow(r, hi)]; a0[r] += st.o0[r] * f; a1[r] += st.o1[r] * f; }
}
template <bool DOV, class RowF, class NextF, class BodyF>
__device__ __forceinline__ void nsa_stream(LAS unsigned char* lds, const bf16_t* base, int kcol, int vcol, int first, const RowF& rowf, const NextF& nextf, const BodyF& body, int wave, int lane) {
    const unsigned lds0 = (unsigned)(uintptr_t)lds;
    auto dma = [&](const char* gsrc, unsigned ldsoff) { unsigned keep_;
        asm volatile("s_mov_b32 %0, m0\n\ts_mov_b32 m0, %2\n\ts_nop 0\n\tglobal_load_lds_dwordx4 %1, off\n\ts_mov_b32 m0, %0" : "=&s"(keep_) : "v"(gsrc), "s"((unsigned)__builtin_amdgcn_readfirstlane(lds0 + ldsoff)) : "memory"); };
    auto issue = [&](int t, int slot) {
        dma((const char*)(base + rowf(t, lane) + kcol) + wave * 16, (unsigned)(slot * NSA_TB + wave * 1024));
        if (DOV) dma((const char*)(base + rowf(t, 16 * (wave & 3) + (lane >> 2)) + vcol) + (wave >> 2) * 64 + (lane & 3) * 16, (unsigned)(slot * NSA_TB + 8192 + wave * 1024)); };
    int c0 = first, c1 = c0 >= 0 ? nextf(c0) : -1, pr = 0;
    asm volatile("s_waitcnt vmcnt(0) lgkmcnt(0)" ::: "memory");
    __syncthreads();
    if (c0 >= 0) issue(c0, 0);
    if (c1 >= 0) issue(c1, 1);
    while (c0 >= 0) {
        const int n0 = c1 >= 0 ? nextf(c1) : -1, n1 = n0 >= 0 ? nextf(n0) : -1;
        asm volatile("s_waitcnt vmcnt(0) lgkmcnt(0)\n\ts_barrier" ::: "memory");
        if (n0 >= 0) issue(n0, (pr ^ 1) * 2);
        if (n1 >= 0) issue(n1, (pr ^ 1) * 2 + 1);
        body(c0, (const LAS unsigned char*)(lds + (pr * 2) * NSA_TB));
        if (c1 >= 0) body(c1, (const LAS unsigned char*)(lds + (pr * 2 + 1) * NSA_TB));
        c0 = n0; c1 = n1; pr ^= 1;
    }
}

__device__ __forceinline__ void nsa_core(const bf16_t* P1, const bf16_t* KV, const float* GATES, bf16_t* ONSA, LAS unsigned char* lds, int bid, int G, int wave, int lane0) {
    const int hh = wave & 3, qs = wave >> 2;
    LAS float* pcs = (LAS float*)(lds + NSA_PCS); LAS unsigned* pcsu = (LAS unsigned*)(lds + NSA_PCS);
    LAS unsigned long long* selm = (LAS unsigned long long*)(lds + NSA_SELM);
    LAS unsigned long long* um = (LAS unsigned long long*)(lds + NSA_UM);
    LAS float* wsf = (LAS float*)(lds + NSA_WSF) + wave * 64;
#define NSA_LV int lane_ = lane0; asm volatile("" : "+v"(lane_)); const int lane = lane_, tid = wave * 64 + lane, r32 = lane & 31, hi = lane >> 5; const int tq = t0 + 32 * qs + r32; (void)tid; (void)hi; (void)tq;
    for (int u = bid; u < 2048; u += G) {
        const int b = u & 7, g = (u >> 3) & 3, ss = (u >> 5) & 7, ii = u >> 8;
        const int qt = (ii & 1) ? (ii * 8 + 7 - ss) : (ii * 8 + ss);
        const int t0 = qt * 64, head = 4 * g + hh;
        bf16x8 qr[4]; float g_cmp, g_sel, g_win;
        f32x16 a0 = {}, a1 = {};
        BrState sc; sc.m = -1e30f; sc.l = 0.f; sc.o0 = (f32x16){}; sc.o1 = (f32x16){};
        const int nvmax = ((t0 + 63 - 31) >> 4) + 1;
        const int nct = (nvmax + 63) >> 6;
        auto cmp_row = [&](int tl, int key) -> long { int n = 64 * tl + key; n = n < 255 ? n : 254; return (long)(((size_t)b * 256 + n) * 4 + g) * 128; };
        auto cmp_next = [&](int tl) -> int { return tl + 1 < nct ? tl + 1 : -1; };
        {   NSA_LV
            const size_t tok = (size_t)b * S + tq;
#pragma unroll
            for (int d0 = 0; d0 < 4; ++d0) qr[d0] = ldg16h(P1 + tok * FF + head * 64 + 16 * d0 + 8 * hi);
            g_cmp = GATES[tok * 48 + head * 3 + 0]; g_sel = GATES[tok * 48 + head * 3 + 1]; g_win = GATES[tok * 48 + head * 3 + 2];
            for (int i = tid; i < PCS_LD * 256; i += 512) pcs[i] = 0.f;
            const int nv = (tq >= 31) ? ((tq - 31) >> 4) + 1 : 0;
            nsa_stream<true>(lds, KV, 0, 64, 0, cmp_row, cmp_next, [&](int tl, const LAS unsigned char* tb) {
                f32x16 p0, p1; nsa_qkt(p0, p1, tb, qr, r32, hi);
#pragma unroll
                for (int r = 0; r < 16; ++r) { const int n = 64 * tl + crow(r, hi); if (n >= nv) p0[r] = -INFINITY; if (n + 32 >= nv) p1[r] = -INFINITY; }
                nsa_update(sc, p0, p1, tb, wsf, r32, hi, lane, true); }, wave, lane);
            nsa_finish(sc, a0, a1, g_cmp, wsf, r32, hi);
        }
        {   NSA_LV
            const int nv = (tq >= 31) ? ((tq - 31) >> 4) + 1 : 0;
            const float lt = half_swap_sum(sc.l); const float il2 = lt > 0.f ? 67108864.f / lt : 0.f;
            for (int tl = 0; tl < nct; ++tl) { const LAS unsigned char* tb = lds + tl * NSA_TB;
                f32x16 p0, p1; nsa_qkt(p0, p1, tb, qr, r32, hi);
#pragma unroll
                for (int r = 0; r < 16; ++r) { const int n = 64 * tl + crow(r, hi);
                    if (n < nv) { const unsigned lo = (unsigned)(fast_exp2(p0[r] - sc.m) * il2 + 0.5f), hi2 = (n + 32 < nv) ? (unsigned)(fast_exp2(p1[r] - sc.m) * il2 + 0.5f) : 0u;
                        __hip_atomic_fetch_add((LAS unsigned long long*)pcsu + ((tl * 32 + crow(r, hi)) * PCS_LD + qs * 32 + r32), ((unsigned long long)hi2 << 32) | lo, __ATOMIC_RELAXED, __HIP_MEMORY_SCOPE_WORKGROUP); } } }
        }
        __syncthreads();
        {   NSA_LV
            const int qi = lane >> 3, oc = lane & 7, q = 8 * wave + qi, cur = qt;
            unsigned key[8];
#pragma unroll
            for (int r = 0; r < 8; ++r) { const int j = 8 * oc + r; unsigned imp = 0u;
#pragma unroll
                for (int k = 0; k < 5; ++k) { const int n = 4 * j - 1 + k; if (n >= 0 && n < 255) imp += pcsu[2 * (((n >> 6) * 32 + (n & 31)) * PCS_LD + q) + ((n >> 5) & 1)]; }
                unsigned kk = imp + 1u;
                if (j == 0 || j == cur || j == cur - 1) kk = 0x7f000000u;
                key[r] = (j <= cur) ? kk : 0u; }
            auto gsum = [&](int v) -> int {
                v += __builtin_amdgcn_update_dpp(0, v, 0xB1, 0xF, 0xF, true); v += __builtin_amdgcn_update_dpp(0, v, 0x4E, 0xF, 0xF, true); v += __builtin_amdgcn_update_dpp(0, v, 0x141, 0xF, 0xF, true); return v; };
            unsigned selb = 0u;
            if (cur < 16) {
#pragma unroll
                for (int r = 0; r < 8; ++r) selb |= (key[r] != 0u) ? (1u << r) : 0u;
            } else {
                unsigned Tk = 0u; int cTk = 64;
                { const unsigned cand = 1u << 30; int c = 0;
#pragma unroll
                  for (int r = 0; r < 8; ++r) c += (key[r] >= cand) ? 1 : 0;
                  c = gsum(c); if (c >= 16) { Tk = cand; cTk = c; } }
#pragma unroll 1
                for (int bit = 28; bit >= 0; bit -= 2) {
                    if (__all(cTk == 16)) break;
                    const unsigned c1 = Tk | (1u << bit), c2 = Tk | (2u << bit), c3 = Tk | (3u << bit); int n1 = 0, n2 = 0, n3 = 0;
#pragma unroll
                    for (int r = 0; r < 8; ++r) { n1 += (key[r] >= c1) ? 1 : 0; n2 += (key[r] >= c2) ? 1 : 0; n3 += (key[r] >= c3) ? 1 : 0; }
                    n1 = gsum(n1); n2 = gsum(n2); n3 = gsum(n3);
                    if (n3 >= 16) { Tk = c3; cTk = n3; } else if (n2 >= 16) { Tk = c2; cTk = n2; } else if (n1 >= 16) { Tk = c1; cTk = n1; } }
                int cgt = 0, ceq = 0;
#pragma unroll
                for (int r = 0; r < 8; ++r) { cgt += (key[r] > Tk) ? 1 : 0; ceq += (key[r] == Tk) ? 1 : 0; }
                const int need_eq = 16 - gsum(cgt);
                int pre = ceq;
                { int v = __shfl_up(pre, 1, 8); if (oc >= 1) pre += v; v = __shfl_up(pre, 2, 8); if (oc >= 2) pre += v; v = __shfl_up(pre, 4, 8); if (oc >= 4) pre += v; }
                int eqi = pre - ceq;
#pragma unroll
                for (int r = 0; r < 8; ++r) { const bool gt = key[r] > Tk, eq = key[r] == Tk; const bool take = gt || (eq && eqi < need_eq); eqi += eq ? 1 : 0; selb |= take ? (1u << r) : 0u; }
            }
            unsigned mlo = oc < 4 ? (selb << (8 * oc)) : 0u, mhi = oc >= 4 ? (selb << (8 * (oc - 4))) : 0u;
            mlo |= (unsigned)__builtin_amdgcn_update_dpp(0, (int)mlo, 0xB1, 0xF, 0xF, true); mhi |= (unsigned)__builtin_amdgcn_update_dpp(0, (int)mhi, 0xB1, 0xF, 0xF, true);
            mlo |= (unsigned)__builtin_amdgcn_update_dpp(0, (int)mlo, 0x4E, 0xF, 0xF, true); mhi |= (unsigned)__builtin_amdgcn_update_dpp(0, (int)mhi, 0x4E, 0xF, 0xF, true);
            mlo |= (unsigned)__builtin_amdgcn_update_dpp(0, (int)mlo, 0x141, 0xF, 0xF, true); mhi |= (unsigned)__builtin_amdgcn_update_dpp(0, (int)mhi, 0x141, 0xF, 0xF, true);
            if (oc == 0) selm[q] = ((unsigned long long)mhi << 32) | mlo;
            unsigned ulo = mlo, uhi = mhi;
#pragma unroll
            for (int o = 8; o < 64; o <<= 1) { ulo |= (unsigned)__shfl_xor((int)ulo, o); uhi |= (unsigned)__shfl_xor((int)uhi, o); }
            const unsigned long long uni = ((unsigned long long)uhi << 32) | ulo;
            if (lane == 0) um[wave] = uni;
        }
        __syncthreads();
        {   NSA_LV
            unsigned long long umask = 0ull;
#pragma unroll
            for (int w = 0; w < 8; ++w) umask |= um[w];
            const unsigned long long mymask = selm[32 * qs + r32];
            BrState sb; sb.m = -1e30f; sb.l = 0.f; sb.o0 = (f32x16){}; sb.o1 = (f32x16){};
            auto nextsel = [&](int j) -> int { const unsigned long long rest = (j >= 63) ? 0ull : (umask >> (j + 1)); if (rest == 0ull) return -1; const int nj = j + 1 + __builtin_ctzll(rest); return nj <= qt ? nj : -1; };
            nsa_stream<true>(lds, P1, 1536 + g * 64, 1792 + g * 64, nextsel(-1),
                [&](int j, int key) -> long { return (long)((size_t)b * S + 64 * j + key) * FF; }, nextsel,
                [&](int j, const LAS unsigned char* tb) {
                    const bool bsel = (mymask >> j) & 1ull;
                    if (!__any(bsel)) return;
                    f32x16 p0, p1; nsa_qkt(p0, p1, tb, qr, r32, hi);
                    if (j == qt) {
#pragma unroll
                        for (int r = 0; r < 16; ++r) { const int pos = 64 * j + crow(r, hi); if (pos > tq) p0[r] = -INFINITY; if (pos + 32 > tq) p1[r] = -INFINITY; } }
                    nsa_update(sb, p0, p1, tb, wsf, r32, hi, lane, bsel); }, wave, lane);
            nsa_finish(sb, a0, a1, g_sel, wsf, r32, hi);
        }
        {   NSA_LV
            BrState sw; sw.m = -1e30f; sw.l = 0.f; sw.o0 = (f32x16){}; sw.o1 = (f32x16){};
            const int j0 = (t0 - 511) > 0 ? (t0 - 511) >> 6 : 0;
            nsa_stream<true>(lds, P1, 2048 + g * 64, 2304 + g * 64, j0,
                [&](int j, int key) -> long { return (long)((size_t)b * S + 64 * j + key) * FF; },
                [&](int j) -> int { return j < qt ? j + 1 : -1; },
                [&](int j, const LAS unsigned char* tb) {
                    f32x16 p0, p1; nsa_qkt(p0, p1, tb, qr, r32, hi);
                    const int tqmin = t0 + 32 * qs;
                    if (!(64 * j + 63 <= tqmin && 64 * j > tqmin + 31 - 512)) {
#pragma unroll
                        for (int r = 0; r < 16; ++r) { const int pos = 64 * j + crow(r, hi);
                            if (pos > tq || pos <= tq - 512) p0[r] = -INFINITY; if (pos + 32 > tq || pos + 32 <= tq - 512) p1[r] = -INFINITY; } }
                    nsa_update(sw, p0, p1, tb, wsf, r32, hi, lane, true); }, wave, lane);
            nsa_finish(sw, a0, a1, g_win, wsf, r32, hi);
        }
        __syncthreads();
        {   NSA_LV
            LAS bf16_t* stg = (LAS bf16_t*)(lds + NSA_OST) + wave * 2048;
#pragma unroll
            for (int r = 0; r < 16; ++r) { const int orow = crow(r, hi);
                stg[orow * 64 + r32] = (bf16_t)(cvtpk(a0[r], 0.f) & 0xffffu); stg[orow * 64 + 32 + r32] = (bf16_t)(cvtpk(a1[r], 0.f) & 0xffffu); }
            asm volatile("s_waitcnt lgkmcnt(0)" ::: "memory");
            bf16_t* ob = ONSA + ((size_t)b * S + t0 + 32 * qs) * D + head * 64;
#pragma unroll
            for (int i = 0; i < 4; ++i) { const int row = i * 8 + (lane >> 3), ch = lane & 7; const u32x4 v = *(const LAS u32x4*)(stg + row * 64 + ch * 8); stg16(ob + (size_t)row * D + ch * 8, v); }
        }
        __syncthreads();
    }
#undef NSA_LV
}

__device__ __forceinline__ bool moe_chunk(const unsigned* cnt, int c, int& e_out, int& tile0, int& ntl) {
    int ci = 0, toff = 0;
    for (int e = 0; e < NE; ++e) { const int nte = ((int)cnt[e] + 255) >> 8;
        for (int s = 0; s < nte; s += CAPT) { if (ci == c) { e_out = e; tile0 = toff + s; ntl = (nte - s) < CAPT ? (nte - s) : CAPT; return true; } ++ci; }
        toff += nte; }
    return false;
}
__device__ __forceinline__ int moe_nchunks(const unsigned* cnt) { int ci = 0; for (int e = 0; e < NE; ++e) { const int nte = ((int)cnt[e] + 255) >> 8; ci += (nte + CAPT - 1) / CAPT; } return ci; }

__device__ __forceinline__ void moe_route(const float* X, const float* g, const float* mod, const float* wr, unsigned* gcnt, int* ROUTEE, float* ROUTEG,
                                          LAS unsigned char* lds, int bid, int G, int wave, int lane) {
    const int tidx = wave * 64 + lane;
    LAS unsigned* lcnt = (LAS unsigned*)lds;
    LAS int* le = (LAS int*)(lds + 64);
    LAS float* lg = (LAS float*)(lds + 64 + 1024);
    f32x4 wq0[16], wq1[16];
#pragma unroll
    for (int j = 0; j < 4; ++j)
#pragma unroll
        for (int q = 0; q < 4; ++q) { const int c = 4 * lane + 256 * j + q; wq0[4 * j + q] = ldg16f(wr + (size_t)c * 8); wq1[4 * j + q] = ldg16f(wr + (size_t)c * 8 + 4); }
    for (int blk = bid; blk < T / 128; blk += G) {
        __syncthreads();
        if (tidx < 16) lcnt[tidx] = 0u;
        __syncthreads();
        f32x4 vn[4];
#pragma unroll
        for (int j = 0; j < 4; ++j) vn[j] = ldg16f(X + (size_t)(blk * 128 + wave * 16) * D + 4 * lane + 256 * j);
        for (int i = 0; i < 16; ++i) {
            const int tl = wave * 16 + i, m = blk * 128 + tl; const float* modb = mod + (size_t)(m >> 12) * 3072;
            f32x4 v[4]; float ss = 0.f;
#pragma unroll
            for (int j = 0; j < 4; ++j) v[j] = vn[j];
            { const int mn = blk * 128 + wave * 16 + (i + 1 < 16 ? i + 1 : i);
#pragma unroll
              for (int j = 0; j < 4; ++j) vn[j] = ldg16f(X + (size_t)mn * D + 4 * lane + 256 * j); }
#pragma unroll
            for (int j = 0; j < 4; ++j) ss += (v[j][0] * v[j][0] + v[j][1] * v[j][1]) + (v[j][2] * v[j][2] + v[j][3] * v[j][3]);
            const float r = 1.f / sqrtf(wave_sum(ss) * (1.f / D) + EPS);
            float lg8[8];
#pragma unroll
            for (int e = 0; e < 8; ++e) lg8[e] = 0.f;
#pragma unroll
            for (int j = 0; j < 4; ++j) { const int c = 4 * lane + 256 * j;
                const f32x4 gv = *(const f32x4*)(g + c), sh = *(const f32x4*)(modb + c), sc = *(const f32x4*)(modb + D + c);
                const f32x4 y = (v[j] * r) * gv * (sc + 1.f) + sh;
#pragma unroll
                for (int q = 0; q < 4; ++q) { const f32x4 w0 = wq0[4 * j + q], w1 = wq1[4 * j + q];
                    lg8[0] += y[q] * w0[0]; lg8[1] += y[q] * w0[1]; lg8[2] += y[q] * w0[2]; lg8[3] += y[q] * w0[3];
                    lg8[4] += y[q] * w1[0]; lg8[5] += y[q] * w1[1]; lg8[6] += y[q] * w1[2]; lg8[7] += y[q] * w1[3]; } }
#pragma unroll
            for (int e = 0; e < 8; ++e) lg8[e] = wave_sum(lg8[e]);
            int e0 = 0; float l0 = lg8[0];
#pragma unroll
            for (int e = 1; e < 8; ++e) if (lg8[e] > l0) { l0 = lg8[e]; e0 = e; }
            int e1 = -1; float l1 = -INFINITY;
#pragma unroll
            for (int e = 0; e < 8; ++e) if (e != e0 && lg8[e] > l1) { l1 = lg8[e]; e1 = e; }
            const float g0 = 1.f / (1.f + __expf(l1 - l0)), g1 = 1.f - g0;
            if (lane == 0) {
                const unsigned p0 = __hip_atomic_fetch_add(lcnt + e0, 1u, __ATOMIC_RELAXED, __HIP_MEMORY_SCOPE_WORKGROUP);
                const unsigned p1 = __hip_atomic_fetch_add(lcnt + e1, 1u, __ATOMIC_RELAXED, __HIP_MEMORY_SCOPE_WORKGROUP);
                le[tl * 2] = e0 | (int)(p0 << 4); le[tl * 2 + 1] = e1 | (int)(p1 << 4); lg[tl * 2] = g0; lg[tl * 2 + 1] = g1; }
        }
        __syncthreads();
        if (tidx < 8) lcnt[8 + tidx] = __hip_atomic_fetch_add(gcnt + tidx, lcnt[tidx], __ATOMIC_RELAXED, __HIP_MEMORY_SCOPE_AGENT);
        __syncthreads();
        if (tidx < 256) { const int ent = tidx; const int v = le[ent]; const int e = v & 15; const int pos = (v >> 4) + (int)lcnt[8 + e];
            ROUTEE[(size_t)blk * 256 + ent] = e | (pos << 4); ROUTEG[(size_t)blk * 256 + ent] = lg[ent]; }
    }
}
__device__ __forceinline__ void moe_fill(const float* X, const float* g, const float* mod, const unsigned* cnt, const int* ROUTEE, const float* ROUTEG,
                                         bf16_t* AMOE, int* SLOTTOK, float* SLOTGATE, LAS int* offl, int wave, int gw, int NGW, int lane) {
    auto offs = [&](int ee) -> int { int a = 0; for (int e = 0; e < NE; ++e) { if (e < ee) a += (((int)cnt[e] + 255) >> 8) << 8; } return a; };
    if (wave == 0 && lane < NE) offl[lane] = offs(lane);
    __syncthreads();
    f32x4 vn[4]; int ran, rbn;
    { const int m0 = gw < T ? gw : T - 1;
#pragma unroll
      for (int j = 0; j < 4; ++j) vn[j] = ldg16f(X + (size_t)m0 * D + (8 * lane + 4 * (j & 1) + 512 * (j >> 1)));
      ran = ROUTEE[(size_t)m0 * 2]; rbn = ROUTEE[(size_t)m0 * 2 + 1]; }
    for (int m = gw; m < T; m += NGW) {
        const float* modb = mod + (size_t)(m >> 12) * 3072;
        f32x4 v[4]; float ss = 0.f;
#pragma unroll
        for (int j = 0; j < 4; ++j) v[j] = vn[j];
        const int ra = ran, rb = rbn;
        { const int mn = (m + NGW < T) ? m + NGW : m;
#pragma unroll
          for (int j = 0; j < 4; ++j) vn[j] = ldg16f(X + (size_t)mn * D + (8 * lane + 4 * (j & 1) + 512 * (j >> 1)));
          ran = ROUTEE[(size_t)mn * 2]; rbn = ROUTEE[(size_t)mn * 2 + 1]; }
#pragma unroll
        for (int j = 0; j < 4; ++j) ss += (v[j][0] * v[j][0] + v[j][1] * v[j][1]) + (v[j][2] * v[j][2] + v[j][3] * v[j][3]);
        const float r = 1.f / sqrtf(wave_sum(ss) * (1.f / D) + EPS);
        const int oa = offl[ra & 15], ob = offl[rb & 15];
        const size_t sa = (size_t)(oa + (ra >> 4)), sb = (size_t)(ob + (rb >> 4));
#pragma unroll
        for (int jj = 0; jj < 2; ++jj) { u32x4 o;
#pragma unroll
            for (int q = 0; q < 2; ++q) { const int j = 2 * jj + q; const int c = (8 * lane + 4 * (j & 1) + 512 * (j >> 1));
                const f32x4 gv = *(const f32x4*)(g + c), sh = *(const f32x4*)(modb + c), sc = *(const f32x4*)(modb + D + c);
                const f32x4 y = (v[j] * r) * gv * (sc + 1.f) + sh;
                if (q == 0) { o.x = cvtpk(y[0], y[1]); o.y = cvtpk(y[2], y[3]); } else { o.z = cvtpk(y[0], y[1]); o.w = cvtpk(y[2], y[3]); } }
            stg16(AMOE + sa * D + 8 * lane + 512 * jj, o); stg16(AMOE + sb * D + 8 * lane + 512 * jj, o); }
        if (lane == 0) { SLOTTOK[sa] = m; SLOTTOK[sb] = m; SLOTGATE[sa] = ROUTEG[(size_t)m * 2]; SLOTGATE[sb] = ROUTEG[(size_t)m * 2 + 1]; }
    }
    for (int pr = gw; pr < NE * 256; pr += NGW) { const int e = pr >> 8, i = pr & 255; const int oe = offs(e), ce = (int)cnt[e];
        const int padn = ((ce + 255) & ~255) - ce;
        if (i < padn) { const size_t sr = (size_t)(oe + ce + i);
#pragma unroll
            for (int j = 0; j < 4; ++j) *(u32x2*)(AMOE + sr * D + 4 * lane + 256 * j) = (u32x2){0u, 0u};
            if (lane == 0) { SLOTTOK[sr] = -1; SLOTGATE[sr] = 0.f; } } }
}
__device__ __forceinline__ void final_rows_subset(const float* X, const float* g, float* out, const int* ROUTEE, int e_last, bool want_last, int gw, int NGW, int lane) {
    for (int m = gw; m < T; m += NGW) {
        const int ra = ROUTEE[(size_t)m * 2] & 15, rb = ROUTEE[(size_t)m * 2 + 1] & 15;
        const bool has = (ra == e_last) || (rb == e_last);
        if (has != want_last) continue;
        f32x4 va[4]; float sa = 0.f;
#pragma unroll
        for (int j = 0; j < 4; ++j) va[j] = ldg16f(X + (size_t)m * D + 4 * lane + 256 * j);
#pragma unroll
        for (int j = 0; j < 4; ++j) sa += (va[j][0] * va[j][0] + va[j][1] * va[j][1]) + (va[j][2] * va[j][2] + va[j][3] * va[j][3]);
        const float ra_ = 1.f / sqrtf(wave_sum(sa) * (1.f / D) + EPS);
#pragma unroll
        for (int j = 0; j < 4; ++j) { const int c = 4 * lane + 256 * j; *(GAS f32x4*)(out + (size_t)m * D + c) = (va[j] * ra_) * *(const f32x4*)(g + c); }
    }
}
__device__ __forceinline__ void final_rows_subset_b(const float* X, const float* g, float* out, const int* ROUTEE, int e_last, bool want_last, int gw, int NGW, int lane) {
    for (int base = gw; base < T; base += 16 * NGW) {
        int ra[16], rb[16];
#pragma unroll
        for (int i = 0; i < 16; ++i) { const int m = base + i * NGW, mc = m < T ? m : T - 1; ra[i] = ROUTEE[(size_t)mc * 2] & 15; rb[i] = ROUTEE[(size_t)mc * 2 + 1] & 15; }
        unsigned msk = 0u;
#pragma unroll
        for (int i = 0; i < 16; ++i) { const bool has = (ra[i] == e_last) || (rb[i] == e_last); if (base + i * NGW < T && has == want_last) msk |= 1u << i; }
        msk = (unsigned)__builtin_amdgcn_readfirstlane((int)msk);
        if (msk == 0u) continue;
        f32x4 vn[4];
        { const int m0 = base + (int)__builtin_ctz(msk) * NGW;
#pragma unroll
          for (int j = 0; j < 4; ++j) vn[j] = ldg16f(X + (size_t)m0 * D + 4 * lane + 256 * j); }
        while (msk != 0u) {
            const int m = base + (int)__builtin_ctz(msk) * NGW; msk &= msk - 1u;
            f32x4 va[4];
#pragma unroll
            for (int j = 0; j < 4; ++j) va[j] = vn[j];
            { const int mn = msk != 0u ? base + (int)__builtin_ctz(msk) * NGW : m;
#pragma unroll
              for (int j = 0; j < 4; ++j) vn[j] = ldg16f(X + (size_t)mn * D + 4 * lane + 256 * j); }
            float sa = 0.f;
#pragma unroll
            for (int j = 0; j < 4; ++j) sa += (va[j][0] * va[j][0] + va[j][1] * va[j][1]) + (va[j][2] * va[j][2] + va[j][3] * va[j][3]);
            const float ra_ = 1.f / sqrtf(wave_sum(sa) * (1.f / D) + EPS);
#pragma unroll
            for (int j = 0; j < 4; ++j) { const int c = 4 * lane + 256 * j; *(GAS f32x4*)(out + (size_t)m * D + c) = (va[j] * ra_) * *(const f32x4*)(g + c); }
        }
    }
}
__device__ __forceinline__ void final_rows(const float* X, const float* g, float* out, int gw, int NGW, int lane) {
    for (int m = gw; m < T; m += 2 * NGW) { const int m2 = m + NGW;
        f32x4 va[4], vb[4]; float sa = 0.f, sb = 0.f;
#pragma unroll
        for (int j = 0; j < 4; ++j) va[j] = ldg16f(X + (size_t)m * D + 4 * lane + 256 * j);
        if (m2 < T) {
#pragma unroll
            for (int j = 0; j < 4; ++j) vb[j] = ldg16f(X + (size_t)m2 * D + 4 * lane + 256 * j); }
#pragma unroll
        for (int j = 0; j < 4; ++j) sa += (va[j][0] * va[j][0] + va[j][1] * va[j][1]) + (va[j][2] * va[j][2] + va[j][3] * va[j][3]);
        const float ra = 1.f / sqrtf(wave_sum(sa) * (1.f / D) + EPS);
#pragma unroll
        for (int j = 0; j < 4; ++j) { const int c = 4 * lane + 256 * j; *(GAS f32x4*)(out + (size_t)m * D + c) = (va[j] * ra) * *(const f32x4*)(g + c); }
        if (m2 < T) {
#pragma unroll
            for (int j = 0; j < 4; ++j) sb += (vb[j][0] * vb[j][0] + vb[j][1] * vb[j][1]) + (vb[j][2] * vb[j][2] + vb[j][3] * vb[j][3]);
            const float rb = 1.f / sqrtf(wave_sum(sb) * (1.f / D) + EPS);
#pragma unroll
            for (int j = 0; j < 4; ++j) { const int c = 4 * lane + 256 * j; *(GAS f32x4*)(out + (size_t)m2 * D + c) = (vb[j] * rb) * *(const f32x4*)(g + c); } }
    }
}

enum { PH_PRO = 0, PH_MOD0, PH_IN0, PH_DPOST, PH_Q, PH_DSA, PH_WO0, PH_MOD1, PH_UP, PH_DOWN, PH_MOD2, PH_NIN, PH_CMP1, PH_CMP2, PH_NSA, PH_WO1, PH_ROUTE, PH_FILL, PH_MOE0,
       PH_MOE_N = 14, PH_FINAL = PH_MOE0 + PH_MOE_N, PH_COUNT };

#define KPARAMS const float* __restrict__ in0, const float* __restrict__ in1, const float* __restrict__ in2, const float* __restrict__ in3, const float* __restrict__ in4, const float* __restrict__ in5, const float* __restrict__ in6, const float* __restrict__ in7, const float* __restrict__ in8, const float* __restrict__ in9, const float* __restrict__ in10, const float* __restrict__ in11, const float* __restrict__ in12, const float* __restrict__ in13, const float* __restrict__ in14, const float* __restrict__ in15, const float* __restrict__ in16, const float* __restrict__ in17, const float* __restrict__ in18, const float* __restrict__ in19, const float* __restrict__ in20, const float* __restrict__ in21, const float* __restrict__ in22, const float* __restrict__ in23, const float* __restrict__ in24, const float* __restrict__ in25, const float* __restrict__ in26, const float* __restrict__ in27, const float* __restrict__ in28, float* out_p, unsigned char* ws_p, int ph_lo, int ph_hi
__global__ void __launch_bounds__(512, 2) fwd_kernel(KPARAMS) {
    const float* const in[29] = {in0, in1, in2, in3, in4, in5, in6, in7, in8, in9, in10, in11, in12, in13, in14, in15, in16, in17, in18, in19, in20, in21, in22, in23, in24, in25, in26, in27, in28};
    extern __shared__ __attribute__((aligned(16))) unsigned char lds_raw[];
    LAS unsigned char* lds = (LAS unsigned char*)lds_raw;
#if MK_SPLIT
#define IN(k) (PH_EN(k) && ph_lo <= (k) && (k) < ph_hi)
#define GRID_BAR() do { } while (0)
#else
#define IN(k) PH_EN(k)
    if (threadIdx.x < 4) ((LAS unsigned*)(lds + LDS_MISC))[threadIdx.x] = 0u;
    __syncthreads();
    (void)xcd_barrier_post((unsigned*)(ws_p + WS_CTL) + CW_BAR, (volatile LAS unsigned*)(lds + LDS_MISC));
#define GRID_BAR() do { XcdBarrier _b; _b.bar = (unsigned*)(ws_p + WS_CTL) + CW_BAR; _b.x = xb_xcc_id(); _b.st = (volatile LAS unsigned*)(lds + LDS_MISC); int _ln; asm volatile("v_mbcnt_lo_u32_b32 %0, -1, 0\n\tv_mbcnt_hi_u32_b32 %0, -1, %0" : "=v"(_ln)); xcd_barrier(_b, (wave0 == 0) && (_ln == 0)); } while (0)
#endif
    const int wave0 = __builtin_amdgcn_readfirstlane(threadIdx.x >> 6);
#define PHV size_t wsz_ = 0; asm volatile("" : "+s"(wsz_)); unsigned char* ws = ws_p + wsz_; int lane; asm volatile("v_mbcnt_lo_u32_b32 %0, -1, 0\n\tv_mbcnt_hi_u32_b32 %0, -1, %0" : "=v"(lane)); \
    int wave = wave0; asm volatile("" : "+s"(wave)); const int tid = wave * 64 + lane; const int G = gridDim.x, bid = blockIdx.x; const int gw = bid * 8 + wave, NGW = G * 8; (void)tid; \
    LAS float* scr = (LAS float*)(lds + wave * 8448); (void)lane; (void)gw; (void)NGW; (void)scr; (void)ws;
#define MOD ((float*)(ws + WS_MOD))
#define ROPEC ((float*)(ws + WS_ROPEC))
#define ROPES ((float*)(ws + WS_ROPES))
#define BIASKV ((float*)(ws + WS_BIASKV))
#define X ((float*)(ws + WS_X))
#define H ((bf16_t*)(ws + WS_H))
#define gcnt ((unsigned*)(ws + WS_CTL) + CW_MOECNT)
#define modF (MOD + 3 * 8 * 3072)

    for (int rep_pro = 0; rep_pro < PROBE_REP_PRO; ++rep_pro)
    if (IN(PH_PRO)) { PHV
        for (int i = bid * 512 + tid; i < S * 8; i += G * 512) { const int pos = i >> 3, j = i & 7;
            const float inv = powf(500000.0f, -(float)(2 * j) / 16.0f); const float ang = (float)pos * inv; ROPEC[i] = cosf(ang); ROPES[i] = sinf(ang); }
        LAS float* red = (LAS float*)(lds + 8 * 8448); LAS float* act = (LAS float*)(lds + 8 * 8448 + 16384);
        if (bid < 192) { const int ls = bid / 48, cb = bid % 48;
            const float* cp = in[I_C];
            for (int i = tid; i < 8 * D; i += 512) { const float v = cp[i]; act[i] = v / (1.f + __expf(-v)); }
            __syncthreads();
            gemv_item<8>(act, in[I_ADA_W] + (size_t)ls * D * 3072, 3072, D, cb * 64, in[I_ADA_B] + ls * 3072, MOD + (size_t)ls * 8 * 3072, 3072, red, wave, lane); }
        else if (bid < 200) { const int it = bid - 192, mat = it >> 2, cb = it & 3;
            const float* pe = in[I_NSA_CMP_PE];
            for (int i = tid; i < 2048; i += 512) act[i] = pe[i];
            __syncthreads();
            gemv_item<1>(act, mat ? in[I_NSA_CMP_V1] : in[I_NSA_CMP_K1], 256, 2048, cb * 64, nullptr, BIASKV + mat * 256, 0, red, wave, lane); }
        {
            float* TMPQ = (float*)(ws + WS_TMPQ); float* TMPO = (float*)(ws + WS_TMPO);
            const float* wuq = in[I_DSA_W_UQ]; const float* wuk = in[I_DSA_W_UK]; const float* wuv = in[I_DSA_W_UV]; const float* wo = in[I_DSA_W_O];
            for (int i = bid * 512 + tid; i < 256 * 2048; i += 2 * G * 512) {
                const int i2 = i + G * 512, i2c = i2 < 256 * 2048 ? i2 : i;
                const int k = i >> 11, hc = i & 2047, h = hc >> 7, k2 = i2c >> 11, hc2 = i2c & 2047, h2 = hc2 >> 7;
                f32x4 qa[12], ka[12], qb[12], kb[12];
#pragma unroll
                for (int j = 0; j < 12; ++j) { qa[j] = ldg16f(wuq + (size_t)k * 1024 + h * 64 + 16 + 4 * j); ka[j] = ldg16f(wuk + (size_t)hc * 48 + 4 * j); }
#pragma unroll
                for (int j = 0; j < 12; ++j) { qb[j] = ldg16f(wuq + (size_t)k2 * 1024 + h2 * 64 + 16 + 4 * j); kb[j] = ldg16f(wuk + (size_t)hc2 * 48 + 4 * j); }
                float a = 0.f, a2 = 0.f;
#pragma unroll
                for (int j = 0; j < 12; ++j) a += (qa[j][0] * ka[j][0] + qa[j][1] * ka[j][1]) + (qa[j][2] * ka[j][2] + qa[j][3] * ka[j][3]);
#pragma unroll
                for (int j = 0; j < 12; ++j) a2 += (qb[j][0] * kb[j][0] + qb[j][1] * kb[j][1]) + (qb[j][2] * kb[j][2] + qb[j][3] * kb[j][3]);
                TMPQ[i] = a; if (i2 < 256 * 2048) TMPQ[i2] = a2; }
            for (int i = bid * 512 + tid; i < 2048 * 256; i += G * 512) { const int hc = i >> 8, n4 = i & 255, h = hc >> 7;
                f32x4 acc = {0.f, 0.f, 0.f, 0.f};
                const float* wop = wo + (size_t)(h * 64) * 1024 + 4 * n4; const float* wvp = wuv + (size_t)hc * 64;
#pragma unroll 1
                for (int vb = 0; vb < 4; ++vb, wop += 16 * 1024, wvp += 16) {
                    f32x4 wv4[4], wo16[16];
#pragma unroll
                    for (int j = 0; j < 4; ++j) wv4[j] = ldg16f(wvp + 4 * j);
#pragma unroll
                    for (int j = 0; j < 16; ++j) wo16[j] = ldg16f(wop + (size_t)j * 1024);
#pragma unroll
                    for (int j = 0; j < 16; ++j) acc = acc + wo16[j] * wv4[j >> 2][j & 3];
                }
                *(GAS f32x4*)(TMPO + (size_t)hc * 1024 + 4 * n4) = acc; }
        }
        conv_items(F13{in[I_FFN_W1], in[I_FFN_W3], FF}, 2 * FF, 1024, (bf16_t*)(ws + WS_W13), scr, gw, NGW, lane);
        conv_items(FPlain{in[I_FFN_W2], D}, D, FF, (bf16_t*)(ws + WS_W2), scr, gw, NGW, lane);
        conv_items(FNin{in[I_NSA_W_IN]}, FF, 1024, (bf16_t*)(ws + WS_WNIN), scr, gw, NGW, lane);
        conv_items(FPlain{in[I_NSA_W_O], D}, D, D, (bf16_t*)(ws + WS_WNWO), scr, gw, NGW, lane);
        conv_items(FIn0{in[I_DSA_W_IN]}, 512, 1024, (bf16_t*)(ws + WS_WIN0), scr, gw, NGW, lane);
        conv_items(FK1{in[I_NSA_CMP_K1]}, 256, 2048, (bf16_t*)(ws + WS_WK1), scr, gw, NGW, lane);
        conv_items(FPlain{in[I_NSA_CMP_V1], 256}, 256, 2048, (bf16_t*)(ws + WS_WV1), scr, gw, NGW, lane);
        conv_items(FK2V2{in[I_NSA_CMP_K2], in[I_NSA_CMP_V2]}, 256, 512, (bf16_t*)(ws + WS_WK2V2), scr, gw, NGW, lane);
        GRID_BAR();
    }
    if (IN(PH_MOD0)) { PHV
        {   constexpr int nq = (3072 / 32) * (256 / 64), nt = nq + (D / 32) * (2048 / 64);
            for (int it = gw; it < nt; it += NGW) {
                if (it < nq) conv_one(FQ{in[I_DSA_W_UQ], in[I_DSA_W_IQ], (const float*)(ws + WS_TMPQ)}, 3072, 256, (bf16_t*)(ws + WS_WQ), scr, it, lane);
                else conv_one(FPlain{(const float*)(ws + WS_TMPO), D}, D, 2048, (bf16_t*)(ws + WS_WOC), scr, it - nq, lane); } }
        mod_rows(in[I_X], in[I_NORM_MIX], MOD, H, gw, NGW, lane);
        GRID_BAR();
    }
    if (IN(PH_IN0)) { PHV
        pg8::Gemm g{(const char*)H, (const char*)(ws + WS_WIN0), 1024, 2048u, 128u}; pg8::StaticOrder So; So.init(T / 256, 2, G, bid);
        pg8::EpiF32 E{(float*)(ws + WS_PROJ0), 512};
        pg8::gemm_phase<pg8::EpiF32, pg8::MapLinear>(lds, g, So, E, tid);
        GRID_BAR();
    }
    if (IN(PH_DPOST)) { PHV
        dsa_post_rows((const float*)(ws + WS_PROJ0), in[I_DSA_G_Q], in[I_DSA_G_KV], ROPEC, ROPES, (bf16_t*)(ws + WS_QLN), (bf16_t*)(ws + WS_KCAT), (bf16_t*)(ws + WS_IK), (float*)(ws + WS_IW), gw, NGW, lane);
        GRID_BAR();
    }
    if (IN(PH_Q)) { PHV
        { pg8::Gemm g{(const char*)(ws + WS_QLN), (const char*)(ws + WS_WQ), 256, 512u, 128u}; pg8::StaticOrder So; So.init(T / 256, 10, G, bid);
          pg8::EpiQ<true> E{(bf16_t*)(ws + WS_QCAT), ROPEC, ROPES};
          pg8::gemm_phase<pg8::EpiQ<true>, pg8::MapLinear>(lds, g, So, E, tid); }
        { PHV pg8::Gemm g{(const char*)(ws + WS_QLN), (const char*)(ws + WS_WQ) + (size_t)2560 * 256 * 2, 256, 512u, 128u}; pg8::StaticOrder So; So.init(T / 256, 2, G, bid);
          pg8::EpiQ<false> E{(bf16_t*)(ws + WS_IQ), ROPEC, ROPES};
          pg8::gemm_phase<pg8::EpiQ<false>, pg8::MapLinear>(lds, g, So, E, tid); }
        GRID_BAR();
    }
    if (IN(PH_DSA)) { PHV
        dsa_core((const bf16_t*)(ws + WS_IQ), (const bf16_t*)(ws + WS_IK), (const float*)(ws + WS_IW), (const bf16_t*)(ws + WS_QCAT), (const bf16_t*)(ws + WS_KCAT), (bf16_t*)(ws + WS_OLAT), lds, bid, G, wave, lane);
        GRID_BAR();
    }
#if PROBE_REP_DSA > 1
    if (IN(PH_DSA)) { PHV
        dsa_core((const bf16_t*)(ws + WS_IQ), (const bf16_t*)(ws + WS_IK), (const float*)(ws + WS_IW), (const bf16_t*)(ws + WS_QCAT), (const bf16_t*)(ws + WS_KCAT), (bf16_t*)(ws + WS_OLAT), lds, bid, G, wave, lane);
        GRID_BAR();
    }
#endif
    if (IN(PH_WO0)) { PHV
        pg8::Gemm g{(const char*)(ws + WS_OLAT), (const char*)(ws + WS_WOC), 2048, 4096u, 128u}; pg8::StaticOrder So; So.init(T / 256, 4, G, bid);
        pg8::EpiResid E{in[I_X], X, MOD + 0 * 8 * 3072 + 2048, PROBE_DSA_SCALE};
        pg8::gemm_phase<pg8::EpiResid, pg8::MapLinear>(lds, g, So, E, tid);
        GRID_BAR();
    }
    if (IN(PH_MOD1)) { PHV mod_rows(X, in[I_NORM_FFN], MOD + 1 * 8 * 3072, H, gw, NGW, lane); GRID_BAR(); }
    if (IN(PH_UP)) { PHV
        pg8::Gemm g{(const char*)H, (const char*)(ws + WS_W13), 1024, 2048u, 128u}; pg8::StaticOrder So; So.init(T / 256, 22, G, bid);
        pg8::EpiSwiglu E{(bf16_t*)(ws + WS_U), FF};
        pg8::gemm_phase<pg8::EpiSwiglu, pg8::MapLinear>(lds, g, So, E, tid);
        GRID_BAR();
    }
    if (IN(PH_DOWN)) { PHV
        pg8::Gemm g{(const char*)(ws + WS_U), (const char*)(ws + WS_W2), FF, (unsigned)(FF * 2), 128u}; pg8::StaticOrder So; So.init(T / 256, 4, G, bid);
        pg8::EpiResid E{X, X, MOD + 1 * 8 * 3072 + 2048, 1.f};
        pg8::gemm_phase<pg8::EpiResid, pg8::MapLinear>(lds, g, So, E, tid);
        GRID_BAR();
    }
    if (IN(PH_MOD2)) { PHV mod_rows(X, in[I_NORM_MIX] + D, MOD + 2 * 8 * 3072, H, gw, NGW, lane); GRID_BAR(); }
    if (IN(PH_NIN)) { PHV
        pg8::Gemm g{(const char*)H, (const char*)(ws + WS_WNIN), 1024, 2048u, 128u}; pg8::StaticOrder So; So.init(T / 256, 10, G, bid);
        pg8::EpiNsaIn E{(bf16_t*)(ws + WS_PROJ1), (float*)(ws + WS_GATES), ROPEC, ROPES};
        pg8::gemm_phase<pg8::EpiNsaIn, pg8::MapLinear>(lds, g, So, E, tid);
        GRID_BAR();
    }
    if (IN(PH_CMP1)) {
        { PHV pg8::Gemm g{(const char*)(ws + WS_PROJ1) + 1024 * 2, (const char*)(ws + WS_WK1), 2048, (unsigned)(FF * 2), (unsigned)(FF * 2)}; pg8::StaticOrder So; So.init(32, 1, G, bid);
          pg8::EpiCmpH E{(bf16_t*)(ws + WS_CMPH), BIASKV, 0};
          pg8::gemm_phase<pg8::EpiCmpH, pg8::MapCmp>(lds, g, So, E, tid); }
        { PHV pg8::Gemm g{(const char*)(ws + WS_PROJ1) + 1280 * 2, (const char*)(ws + WS_WV1), 2048, (unsigned)(FF * 2), (unsigned)(FF * 2)}; pg8::StaticOrder So; So.init(32, 1, G, (bid + 224) % G);
          pg8::EpiCmpH E{(bf16_t*)(ws + WS_CMPH), BIASKV + 256, 256};
          pg8::gemm_phase<pg8::EpiCmpH, pg8::MapCmp>(lds, g, So, E, tid); }
        { PHV pg8::Gemm g{(const char*)H, (const char*)(ws + WS_WNIN) + (size_t)10 * 256 * 1024 * 2, 1024, 2048u, 128u}; pg8::StaticOrder So; So.init(T / 256, 1, G, (bid + 192) % G);
          pg8::EpiNsaGate E{(float*)(ws + WS_GATES)};
          pg8::gemm_phase<pg8::EpiNsaGate, pg8::MapLinear>(lds, g, So, E, tid); }
        GRID_BAR();
    }
    if (IN(PH_CMP2)) { PHV
        pg8::Gemm g{(const char*)(ws + WS_CMPH), (const char*)(ws + WS_WK2V2), 512, 1024u, 128u}; pg8::StaticOrder So; So.init(32, 1, G, bid);
        pg8::EpiCmpO E{(bf16_t*)(ws + WS_KVCMP)};
        pg8::gemm_phase<pg8::EpiCmpO, pg8::MapLinear>(lds, g, So, E, tid);
        GRID_BAR();
    }
    if (IN(PH_NSA)) { PHV
        nsa_core((const bf16_t*)(ws + WS_PROJ1), (const bf16_t*)(ws + WS_KVCMP), (const float*)(ws + WS_GATES), (bf16_t*)(ws + WS_ONSA), lds, bid, G, wave, lane);
        GRID_BAR();
    }
#if PROBE_REP_NSA > 1
    if (IN(PH_NSA)) { PHV
        nsa_core((const bf16_t*)(ws + WS_PROJ1), (const bf16_t*)(ws + WS_KVCMP), (const float*)(ws + WS_GATES), (bf16_t*)(ws + WS_ONSA), lds, bid, G, wave, lane);
        GRID_BAR();
    }
#endif
    if (IN(PH_WO1)) { PHV
        pg8::Gemm g{(const char*)(ws + WS_ONSA), (const char*)(ws + WS_WNWO), 1024, 2048u, 128u}; pg8::StaticOrder So; So.init(T / 256, 4, G, bid);
        pg8::EpiResid E{X, X, MOD + 2 * 8 * 3072 + 2048, PROBE_NSA_SCALE};
        pg8::gemm_phase<pg8::EpiResid, pg8::MapLinear>(lds, g, So, E, tid);
        GRID_BAR();
    }
    if (IN(PH_ROUTE)) { PHV
        moe_route(X, in[I_NORM_FFN] + D, modF, in[I_MOE_ROUTER], gcnt, (int*)(ws + WS_ROUTEE), (float*)(ws + WS_ROUTEG), lds, bid, G, wave, lane);
        GRID_BAR();
    }
    if (IN(PH_FILL)) { PHV
        moe_fill(X, in[I_NORM_FFN] + D, modF, gcnt, (const int*)(ws + WS_ROUTEE), (const float*)(ws + WS_ROUTEG), (bf16_t*)(ws + WS_AMOE), (int*)(ws + WS_SLOTTOK), (float*)(ws + WS_SLOTGATE), (LAS int*)(lds + 8 * 8448), wave, gw, NGW, lane);
        int e = 0, t0 = 0, nt = 0; if (moe_chunk(gcnt, 0, e, t0, nt))
            conv_items(F13{in[I_MOE_W1] + (size_t)e * D * ED, in[I_MOE_W3] + (size_t)e * D * ED, ED}, 2 * ED, 1024, (bf16_t*)(ws + WS_W13M), scr, gw, NGW, lane);
        GRID_BAR();
    }
    for (int rep_moe = 0; rep_moe < PROBE_REP_MOE; ++rep_moe)
    for (int r = 0; r < PH_MOE_N; ++r) {
        if (!IN(PH_MOE0 + r)) continue;
        { unsigned char* ws = ws_p; if (r > moe_nchunks(gcnt)) continue; }
        int cv_rank, cv_n, e13, e2, n13, n2;
        { unsigned char* ws = ws_p; int e1 = 0, ta = 0, ntp = 0, ntc = 0; const int Gc = gridDim.x, bidc = blockIdx.x;
          const int nd = (r > 0 && moe_chunk(gcnt, r - 1, e1, ta, ntp)) ? ntp * 4 : 0; const int nu = moe_chunk(gcnt, r, e1, ta, ntc) ? ntc * 28 : 0;
          const int per2 = (7 * nd + 2 * nu) / Gc; int ud = (per2 - 7 + 1) / 2; if (ud < 0) ud = 0; if (nd > 0 && ud * nd > nu) ud = nu / nd;
          const int R = nu - nd * ud, nrest = Gc - nd; const int rem = (nrest > 0 && R > 0) ? R % nrest : 0;
          n13 = moe_chunk(gcnt, r + 1, e1, ta, ntc) ? (2 * ED / 32) * (1024 / 64) : 0; n2 = (nu > 0) ? (D / 32) * (ED / 64) : 0;
          cv_n = (MOE_CONV_SLACK && rem > 0) ? nrest - rem : 0; cv_rank = (cv_n > 0 && bidc >= nd + rem) ? bidc - nd - rem : -1;
          int etot = cv_n * 8 * MOE_CONV_ROUNDS; if (etot > n13 + n2) etot = n13 + n2; e13 = etot < n13 ? etot : n13; e2 = etot - e13;
        }
        { PHV int e = 0, t0 = 0, nt = 0;
          if (n13 > e13 && moe_chunk(gcnt, r + 1, e, t0, nt))
              conv_range(F13{in[I_MOE_W1] + (size_t)e * D * ED, in[I_MOE_W3] + (size_t)e * D * ED, ED}, 2 * ED, 1024, (bf16_t*)(ws + WS_W13M + ((r + 1) & 1) * W13M_BYTES), scr, e13, n13, gw, NGW, lane); }
        { PHV int e = 0, t0 = 0, nt = 0;
          if (n2 > e2 && moe_chunk(gcnt, r, e, t0, nt))
              conv_range(FPlain{in[I_MOE_W2] + (size_t)e * ED * D, D}, D, ED, (bf16_t*)(ws + WS_W2M + (r & 1) * W2M_BYTES), scr, e2, n2, gw, NGW, lane); }
        __syncthreads();
        { PHV int e = 0, t0 = 0, nt = 0;
          if (r > 0 && moe_chunk(gcnt, r - 1, e, t0, nt)) {
              pg8::Gemm g{(const char*)(ws + WS_HID + ((r - 1) & 1) * HID_BYTES), (const char*)(ws + WS_W2M + ((r - 1) & 1) * W2M_BYTES), ED, (unsigned)(ED * 2), 128u};
              pg8::ListOrder So; So.nN = 4; So.total = nt * 4; So.first = bid; So.nfirst = 1; So.start2 = So.total; So.stride2 = 0;
              pg8::EpiMoeDown E{X, modF + 2048, (const int*)(ws + WS_SLOTTOK), (const float*)(ws + WS_SLOTGATE), t0 * 256, (rep_moe == 0) ? 1.f : 0.f};
              pg8::gemm_phase<pg8::EpiMoeDown, pg8::MapLinear, pg8::ListOrder>(lds, g, So, E, tid); } }
        { PHV int e = 0, t0 = 0, nt = 0, e2 = 0, t2 = 0, nt2 = 0;
          if (!moe_chunk(gcnt, r, e, t0, nt) && r > 0 && moe_chunk(gcnt, r - 1, e2, t2, nt2)) {
              const int nd = nt2 * 4;
              if (bid >= nd && nd < G) final_rows_subset(X, in[I_FINAL_NORM], out_p, (const int*)(ws + WS_ROUTEE), e2, false, (bid - nd) * 8 + wave, (G - nd) * 8, lane);
          } }
        { PHV int e = 0, t0 = 0, nt = 0;
          if (moe_chunk(gcnt, r, e, t0, nt)) {
              pg8::Gemm g{(const char*)(ws + WS_AMOE) + (size_t)t0 * 256 * D * 2, (const char*)(ws + WS_W13M + (r & 1) * W13M_BYTES), 1024, 2048u, 128u};
              int e2 = 0, t2 = 0, nt2 = 0; const int nd = (r > 0 && moe_chunk(gcnt, r - 1, e2, t2, nt2)) ? nt2 * 4 : 0;
              const int nu = nt * 28; const int per2 = (7 * nd + 2 * nu) / G;
              int ud = (per2 - 7 + 1) / 2; if (ud < 0) ud = 0; if (nd > 0 && ud * nd > nu) ud = nu / nd; if (nd >= G) ud = (nu + G - 1) / G;
              pg8::ListOrder So; So.nN = 28; So.total = nu;
              if (bid < nd) { So.first = bid * ud; So.nfirst = ud; So.start2 = nu; So.stride2 = 0; }
              else { So.first = 0; So.nfirst = 0; So.start2 = nd * ud + (bid - nd); So.stride2 = G - nd; }
              pg8::EpiSwiglu E{(bf16_t*)(ws + WS_HID + (r & 1) * HID_BYTES), ED};
              pg8::gemm_phase<pg8::EpiSwiglu, pg8::MapLinear, pg8::ListOrder>(lds, g, So, E, tid); } }
        if (cv_rank >= 0) {
            __syncthreads();
            { PHV int e = 0, t0 = 0, nt = 0;
              if (e13 > 0 && moe_chunk(gcnt, r + 1, e, t0, nt))
                  conv_range(F13{in[I_MOE_W1] + (size_t)e * D * ED, in[I_MOE_W3] + (size_t)e * D * ED, ED}, 2 * ED, 1024, (bf16_t*)(ws + WS_W13M + ((r + 1) & 1) * W13M_BYTES), scr, 0, e13, cv_rank * 8 + wave, cv_n * 8, lane); }
            { PHV int e = 0, t0 = 0, nt = 0;
              if (e2 > 0 && moe_chunk(gcnt, r, e, t0, nt))
                  conv_range(FPlain{in[I_MOE_W2] + (size_t)e * ED * D, D}, D, ED, (bf16_t*)(ws + WS_W2M + (r & 1) * W2M_BYTES), scr, 0, e2, cv_rank * 8 + wave, cv_n * 8, lane); }
        }
        GRID_BAR();
    }
    if (IN(PH_FINAL)) { PHV
        const int nchf = moe_nchunks(gcnt); int e2 = 0, t2 = 0, nt2 = 0;
        const bool early = nchf > 0 && moe_chunk(gcnt, nchf - 1, e2, t2, nt2) && (nt2 * 4 < G);
        if (early) final_rows_subset_b(X, in[I_FINAL_NORM], out_p, (const int*)(ws + WS_ROUTEE), e2, true, gw, NGW, lane);
        else final_rows(X, in[I_FINAL_NORM], out_p, gw, NGW, lane);
    }
#undef IN
}

extern "C" void kernel_launch(void* const* d_in, const int* in_sizes, int n_in, void* d_out, int out_size, void* d_ws, size_t ws_size, hipStream_t stream) {
    static int grid = 0;
    if (grid == 0) {
        if (n_in != 29 || in_sizes[0] != T * D || out_size != T * D || ws_size < WS_END) { fprintf(stderr, "kernel_launch: unexpected shapes (n_in %d in0 %d out %d ws %zu)\n", n_in, n_in > 0 ? in_sizes[0] : -1, out_size, ws_size); grid = -1; return; }
        int dev = 0, cus = 0, per_cu = 0;
        if (hipGetDevice(&dev) != hipSuccess || hipDeviceGetAttribute(&cus, hipDeviceAttributeMultiprocessorCount, dev) != hipSuccess) { grid = -1; return; }
        if (hipFuncSetAttribute((const void*)fwd_kernel, hipFuncAttributeMaxDynamicSharedMemorySize, LDS_BYTES) != hipSuccess) { fprintf(stderr, "kernel_launch: hipFuncSetAttribute failed\n"); grid = -1; return; }
        if (hipOccupancyMaxActiveBlocksPerMultiprocessor(&per_cu, (const void*)fwd_kernel, 512, LDS_BYTES) != hipSuccess || per_cu < 1) fprintf(stderr, "kernel_launch: occupancy query reports %d\n", per_cu);
        (void)hipGetLastError();
        grid = cus;
    }
    if (grid < 0) return;
    if (hipMemsetAsync((char*)d_ws + WS_CTL, 0, CTL_BYTES, stream) != hipSuccess) return;
    const float* ip[29];
    for (int i = 0; i < 29; ++i) ip[i] = (const float*)d_in[i];
#define KARGS ip[0], ip[1], ip[2], ip[3], ip[4], ip[5], ip[6], ip[7], ip[8], ip[9], ip[10], ip[11], ip[12], ip[13], ip[14], ip[15], ip[16], ip[17], ip[18], ip[19], ip[20], ip[21], ip[22], ip[23], ip[24], ip[25], ip[26], ip[27], ip[28], (float*)d_out, (unsigned char*)d_ws
#if MK_SPLIT
    for (int p = 0; p < PH_COUNT; ++p) hipLaunchKernelGGL(fwd_kernel, dim3(grid), dim3(512), LDS_BYTES, stream, KARGS, p, p + 1);
#else
    hipLaunchKernelGGL(fwd_kernel, dim3(grid), dim3(512), LDS_BYTES, stream, KARGS, 0, (int)PH_COUNT);
#endif
}
```
